# Optimizing an MI355X kernel written in HIP

```python
import math
import jax, jax.numpy as jnp
from jax import lax
import numpy as np

D_MODEL = 1024
BATCH = 4
SEQ = 4096
DEPTH = 2

POOL_WINDOWS = (2, 4, 8, 16)
N_POOL_GROUPS = len(POOL_WINDOWS)
POOL_GROUP_DIM = D_MODEL // 8
POOL_DIM = N_POOL_GROUPS * POOL_GROUP_DIM

N_HEADS = D_MODEL // 128
QK_NOPE = 64
QK_ROPE = 32
V_DIM = 64
Q_LORA = 384
KV_LORA = 256
ROPE_THETA = 10000.0
ATTN_DIM = N_HEADS * V_DIM
Q_BLOCK = 128

D_FF = 4 * D_MODEL

N_MOD = 6
EPS = 1e-6

IN_SPLITS = (POOL_DIM, Q_LORA, KV_LORA, QK_ROPE, D_MODEL, D_MODEL)
D_IN = sum(IN_SPLITS)

kernel_name = "hybrid_pool_mla_gated_adaln"


def rms_norm(x, g):
    xf = x.astype(jnp.float32)
    y = xf * lax.rsqrt(jnp.mean(xf * xf, axis=-1, keepdims=True) + EPS)
    return y.astype(x.dtype) * g


def apply_rope(x, cos, sin):
    half = x.shape[-1] // 2
    x1, x2 = x[..., :half], x[..., half:]
    return jnp.concatenate([x1 * cos - x2 * sin, x2 * cos + x1 * sin], axis=-1)


def pool_mixer(u, w_pool, pool_scale):
    B, S, _ = u.shape
    t = jnp.arange(S)
    outs = []
    for g, w in enumerate(POOL_WINDOWS):
        ug = u[..., g * POOL_GROUP_DIM:(g + 1) * POOL_GROUP_DIM].astype(jnp.float32)
        cs = jnp.cumsum(ug, axis=1)
        lag = jnp.pad(cs, ((0, 0), (w, 0), (0, 0)))[:, :S]
        cnt = jnp.minimum(t + 1, w).astype(jnp.float32)[None, :, None]
        outs.append(((cs - lag) / cnt - ug).astype(u.dtype))
    p = jnp.stack(outs, axis=2)
    y = jnp.einsum('bsgc,gcd->bsgd', p, w_pool).reshape(B, S, POOL_DIM)
    return y * pool_scale


def mla(c_q_raw, c_kv_raw, k_rope_raw, q_norm_g, w_uq, kv_norm_g, w_uk, w_uv, cos, sin):
    B, S, _ = c_q_raw.shape
    c_q = rms_norm(c_q_raw, q_norm_g)
    q = jnp.einsum('bsr,rhd->bshd', c_q, w_uq)
    q_nope = q[..., :QK_NOPE]
    q_rope = apply_rope(q[..., QK_NOPE:], cos[:, :, None, :], sin[:, :, None, :])
    c_kv = rms_norm(c_kv_raw, kv_norm_g)
    k_nope = jnp.einsum('bsr,rhd->bhsd', c_kv, w_uk)
    v = jnp.einsum('bsr,rhd->bhsd', c_kv, w_uv)
    k_rope = apply_rope(k_rope_raw, cos, sin)

    nb = S // Q_BLOCK
    def to_blocks(a):
        d = a.shape[-1]
        return a.reshape(B, nb, Q_BLOCK, N_HEADS, d).transpose(1, 0, 3, 2, 4)
    qn_b = to_blocks(q_nope)
    qr_b = to_blocks(q_rope)
    starts = jnp.arange(nb, dtype=jnp.int32) * Q_BLOCK
    key_pos = jnp.arange(S, dtype=jnp.int32)
    scale = 1.0 / math.sqrt(QK_NOPE + QK_ROPE)
    neg = jnp.finfo(jnp.float32).min

    def attend(args):
        qn, qr, start = args
        s = (jnp.einsum('bhqd,bhkd->bhqk', qn, k_nope)
             + jnp.einsum('bhqd,bkd->bhqk', qr, k_rope)).astype(jnp.float32) * scale
        q_pos = start + jnp.arange(Q_BLOCK, dtype=jnp.int32)
        mask = q_pos[:, None] >= key_pos[None, :]
        p = jax.nn.softmax(jnp.where(mask, s, neg), axis=-1)
        return jnp.einsum('bhqk,bhkd->bhqd', p.astype(v.dtype), v)

    o = lax.map(attend, (qn_b, qr_b, starts))
    return o.transpose(1, 0, 3, 2, 4).reshape(B, S, ATTN_DIM)


def setup_inputs(seed: int = 0) -> dict:
    key = jax.random.key(seed)
    ks = jax.random.split(key, 24)
    f32 = jnp.float32

    def dense(k, shape, fan_in, mult=1.0):
        return jax.random.normal(k, shape, f32) * (mult * fan_in ** -0.5)

    def gain(k, shape):
        return 1.0 + 0.02 * jax.random.normal(k, shape, f32)

    x = jax.random.normal(ks[0], (BATCH, SEQ, D_MODEL), f32)
    c = jax.random.normal(ks[1], (BATCH, D_MODEL), f32)
    offsets = jax.random.randint(ks[2], (BATCH, 1), 0, 1024, dtype=jnp.int32)
    positions = offsets + jnp.arange(SEQ, dtype=jnp.int32)[None, :]
    return {
        "x": x,
        "c": c,
        "positions": positions,
        "ln1_g": gain(ks[3], (DEPTH, D_MODEL)),
        "ln2_g": gain(ks[4], (DEPTH, D_MODEL)),
        "w_ada": dense(ks[5], (DEPTH, D_MODEL, N_MOD * D_MODEL), D_MODEL, 0.5),
        "b_ada": 0.01 * jax.random.normal(ks[6], (DEPTH, N_MOD * D_MODEL), f32),
        "w_in": dense(ks[7], (DEPTH, D_MODEL, D_IN), D_MODEL),
        "q_norm_g": gain(ks[8], (DEPTH, Q_LORA)),
        "w_uq": dense(ks[9], (DEPTH, Q_LORA, N_HEADS, QK_NOPE + QK_ROPE), Q_LORA),
        "kv_norm_g": gain(ks[10], (DEPTH, KV_LORA)),
        "w_uk": dense(ks[11], (DEPTH, KV_LORA, N_HEADS, QK_NOPE), KV_LORA),
        "w_uv": dense(ks[12], (DEPTH, KV_LORA, N_HEADS, V_DIM), KV_LORA),
        "w_pool": dense(ks[13], (DEPTH, N_POOL_GROUPS, POOL_GROUP_DIM, POOL_GROUP_DIM), POOL_GROUP_DIM),
        "pool_scale": gain(ks[14], (DEPTH, POOL_DIM)),
        "p_pool": dense(ks[15], (DEPTH, POOL_DIM, D_MODEL), POOL_DIM),
        "p_attn": dense(ks[16], (DEPTH, ATTN_DIM, D_MODEL), ATTN_DIM),
        "w_out": dense(ks[17], (DEPTH, D_MODEL, D_MODEL), D_MODEL),
        "w_ff1": dense(ks[18], (DEPTH, D_MODEL, D_FF), D_MODEL),
        "w_ff2": dense(ks[19], (DEPTH, D_FF, D_MODEL), D_FF),
        "final_g": gain(ks[20], (D_MODEL,)),
    }


def reference(x, c, positions, ln1_g, ln2_g, w_ada, b_ada, w_in, q_norm_g, w_uq,
              kv_norm_g, w_uk, w_uv, w_pool, pool_scale, p_pool, p_attn, w_out,
              w_ff1, w_ff2, final_g):
    inv_freq = ROPE_THETA ** (-jnp.arange(0, QK_ROPE, 2, dtype=jnp.float32) / QK_ROPE)
    ang = positions.astype(jnp.float32)[..., None] * inv_freq
    cos = jnp.cos(ang).astype(x.dtype)
    sin = jnp.sin(ang).astype(x.dtype)
    c_act = jax.nn.silu(c)
    cuts = np.cumsum(IN_SPLITS)[:-1].tolist()

    for l in range(DEPTH):
        mod = c_act @ w_ada[l] + b_ada[l]
        sh1, sc1, g1, sh2, sc2, g2 = [m[:, None, :] for m in jnp.split(mod, N_MOD, axis=-1)]

        h = rms_norm(x, ln1_g[l]) * (1.0 + sc1) + sh1
        z = h @ w_in[l]
        u_pool, c_q_raw, c_kv_raw, k_rope_raw, gz_a, gz_b = jnp.split(z, cuts, axis=-1)
        y_a = pool_mixer(u_pool, w_pool[l], pool_scale[l]) @ p_pool[l]
        y_b = mla(c_q_raw, c_kv_raw, k_rope_raw, q_norm_g[l], w_uq[l], kv_norm_g[l],
                  w_uk[l], w_uv[l], cos, sin) @ p_attn[l]
        merged = jax.nn.sigmoid(gz_a) * y_a + jax.nn.sigmoid(gz_b) * y_b
        x = x + g1 * (merged @ w_out[l])

        h2 = rms_norm(x, ln2_g[l]) * (1.0 + sc2) + sh2
        x = x + g2 * (jnp.square(jax.nn.relu(h2 @ w_ff1[l])) @ w_ff2[l])

    return rms_norm(x, final_g)
```

```cpp
#include <hip/hip_runtime.h>
#include <hip/hip_cooperative_groups.h>
#include <cstdio>
#include <cstdint>
namespace cg = cooperative_groups;

#ifndef NAIVE_GEMM
#define NAIVE_GEMM 0
#endif
#ifndef NAIVE_ATTN
#define NAIVE_ATTN 0
#endif
#ifndef PHASE_MASK
#define PHASE_MASK 0xFFFFFFu
#endif
#define PEN(k) ((PHASE_MASK >> (k)) & 1u)
#ifndef CG_SYNC
#define CG_SYNC 0
#endif
#ifndef PROBE_MASK
#define PROBE_MASK 0u
#endif
#ifndef MULTI_LAUNCH
#define MULTI_LAUNCH 0
#endif

typedef unsigned short bf16_t;
typedef short bf16x8 __attribute__((ext_vector_type(8)));
typedef float f32x4 __attribute__((ext_vector_type(4)));
typedef float f32x16 __attribute__((ext_vector_type(16)));
typedef unsigned u32x2 __attribute__((ext_vector_type(2)));
typedef unsigned u32x4 __attribute__((ext_vector_type(4)));

constexpr int T = 16384, D = 1024, SEQ = 4096, DFF = 4096;
constexpr int ZA_LD = 1184;
constexpr int ZC_Q = 512, ZC_KV = 896, ZC_KR = 1152;
constexpr int NMOD = 6144;
constexpr float EPS = 1e-6f;
constexpr float QSCALE = 0.10206207261596575f * 1.4426950408889634f;

constexpr size_t MiB = 1u << 20;
constexpr size_t WS_MODP = 1 * MiB;
constexpr size_t WS_MOD = 3 * MiB;
constexpr size_t WS_COS = 4 * MiB;
constexpr size_t WS_SIN = 5 * MiB;
constexpr size_t WS_RSQ = 6 * MiB;
constexpr size_t WS_RSKV = 6 * MiB + 512 * 1024;
constexpr size_t WS_W = 8 * MiB;
constexpr size_t W_IN = 0, W_FF1 = 6815744, W_FF2 = W_FF1 + 8 * MiB, W_OUT = W_FF2 + 8 * MiB, W_PA = W_OUT + 2 * MiB, W_PB = W_PA + 1 * MiB,
                 W_UQ = W_PB + 1 * MiB, W_UKV = W_UQ + 589824, W_POOL = W_UKV + 524288, W_END = W_POOL + 524288;
static_assert(W_END <= 29 * MiB, "weights");
constexpr size_t WS_GA = 37 * MiB, WS_GB = 69 * MiB, WS_AB = 101 * MiB, WS_ZA = 133 * MiB, WS_P = 170 * MiB, WS_Q = 186 * MiB, WS_K = 210 * MiB, WS_VT = 234 * MiB;
constexpr size_t WS_H = 186 * MiB;
constexpr size_t WS_TMP = 133 * MiB;
constexpr size_t WS_MRG = 197 * MiB;
constexpr size_t WS_F = 37 * MiB;
static_assert(WS_F + 128 * MiB <= WS_MRG, "F vs h2");
constexpr size_t WS_H2 = 165 * MiB;
constexpr size_t WS_CNT = 16384;
constexpr size_t WS_SLOTS = 7 * MiB;
constexpr size_t CTL_ZERO_BYTES = 16384 + 4 * 64 * 256;
constexpr int LDS_BYTES = 148480;

struct Params {
    const float* x; const float* c; const int* pos;
    const float *ln1_g, *ln2_g, *w_ada, *b_ada, *w_in, *q_norm_g, *w_uq, *kv_norm_g, *w_uk, *w_uv, *w_pool, *pool_scale, *p_pool, *p_attn, *w_out, *w_ff1, *w_ff2, *final_g;
    float* out; unsigned char* ws;
    int ph_lo, ph_hi, widx, pad;
};

__device__ __forceinline__ unsigned f2bf(float f) { unsigned u = __builtin_bit_cast(unsigned, f); return (u + 0x7fffu + ((u >> 16) & 1u)) >> 16; }
typedef __bf16 bf16x2_t __attribute__((ext_vector_type(2)));
typedef float f32x2_t __attribute__((ext_vector_type(2)));
__device__ __forceinline__ unsigned pk2(float lo, float hi) { const f32x2_t v = {lo, hi}; const bf16x2_t b = __builtin_convertvector(v, bf16x2_t); return __builtin_bit_cast(unsigned, b); }
__device__ __forceinline__ float bf2f(bf16_t v) { return __builtin_bit_cast(float, (unsigned)v << 16); }
__device__ __forceinline__ float bflo(unsigned w) { return __builtin_bit_cast(float, w << 16); }
__device__ __forceinline__ float bfhi(unsigned w) { return __builtin_bit_cast(float, w & 0xffff0000u); }
__device__ __forceinline__ float wave_sum(float v) {
#pragma unroll
    for (int o = 1; o < 64; o <<= 1) v += __shfl_xor(v, o);
    return v;
}
__device__ __forceinline__ float sigmoidf(float v) { return 1.0f / (1.0f + __expf(-v)); }
__device__ __forceinline__ int opaque_tid(int widx) { int l = __builtin_amdgcn_mbcnt_hi(~0u, __builtin_amdgcn_mbcnt_lo(~0u, 0u)); asm volatile("" : "+v"(l)); return widx * 64 + l; }
#define LDS_WAIT() asm volatile("s_waitcnt lgkmcnt(0)" ::: "memory")

constexpr int BM = 256, BK = 64, HALF = 128, HTB = HALF * BK * 2;
__device__ __forceinline__ int lds_byte(int r, int c) { int st = (r >> 4) * 2 + (c >> 5), rr = r & 15, cc = c & 31, ob = rr * 64 + cc * 2; return st * 1024 + (ob ^ (((ob >> 9) & 1) << 5)); }
__device__ __forceinline__ void stage_rc(int b, int& R, int& C) { int st = b / 1024, sb = b % 1024, swz = sb ^ (((sb >> 9) & 1) << 5); R = (st >> 1) * 16 + swz / 64; C = (st & 1) * 32 + (swz % 64) / 2; }

typedef f32x4 acc_t[2][2][4][2];

#if !NAIVE_GEMM
template <class Epi, bool DUAL = false, long A2OFF = 0, long B2OFF = 0, bool PERM = false>
__device__ __forceinline__ void gemm_tile(unsigned char* shm, const bf16_t* __restrict__ A, int lda, const bf16_t* __restrict__ Bt, int ldb, int K, int brow, int bcol, const Epi& epi, int widx) {
#define SA(b, h) (shm + ((b) * 2 + (h)) * HTB)
#define SB(b, h) (shm + (4 + (b) * 2 + (h)) * HTB)
#define STAGE_A(P, br, kt) do { const bf16_t* _g = (A + (size_t)(kt) * BK + ((DUAL && (kt) >= 8) ? (A2OFF - 8 * BK) : 0)) + (size_t)(br) * lda; \
    _Pragma("unroll") for (int _i = 0; _i < 2; ++_i) __builtin_amdgcn_global_load_lds((const unsigned*)(_g + offA[_i]), (unsigned*)((P) + wid * 1024 + _i * 8192), 16, 0, 0); } while (0)
#define STAGE_B(P, br, kt) do { const bf16_t* _g = (Bt + (size_t)(kt) * BK + ((DUAL && (kt) >= 8) ? (B2OFF - 8 * BK) : 0)) + (size_t)(br) * ldb; \
    _Pragma("unroll") for (int _i = 0; _i < 2; ++_i) __builtin_amdgcn_global_load_lds((const unsigned*)(_g + offB[_i]), (unsigned*)((P) + wid * 1024 + _i * 8192), 16, 0, 0); } while (0)
#define LDA(dst, b, h) _Pragma("unroll") for (int m = 0; m < 4; ++m) _Pragma("unroll") for (int k = 0; k < 2; ++k) \
    dst[m][k] = *reinterpret_cast<const bf16x8*>(SA(b, h) + aoff + m * 2048 + k * 1024)
#define LDB(dst, b, h) _Pragma("unroll") for (int n = 0; n < 2; ++n) _Pragma("unroll") for (int k = 0; k < 2; ++k) \
    dst[n][k] = *reinterpret_cast<const bf16x8*>(SB(b, h) + boff + n * 2048 + k * 1024)
#define MMA(ai, bj, At_, Bt_) do { __builtin_amdgcn_s_setprio(1); \
    _Pragma("unroll") for (int m = 0; m < 4; ++m) _Pragma("unroll") for (int n = 0; n < 2; ++n) _Pragma("unroll") for (int k = 0; k < 2; ++k) \
      acc[ai][bj][m][n] = __builtin_amdgcn_mfma_f32_16x16x32_bf16(Bt_[n][k], At_[m][k], acc[ai][bj][m][n], 0, 0, 0); \
    __builtin_amdgcn_s_setprio(0); } while (0)
#define WAIT_V(n) asm volatile("s_waitcnt vmcnt(" #n ")" ::: "memory")
#define WAIT_L(n) asm volatile("s_waitcnt lgkmcnt(" #n ")" ::: "memory")
#define BAR __builtin_amdgcn_s_barrier()
#define SCHED __builtin_amdgcn_sched_barrier(0)
    const int tid = opaque_tid(widx), wid = widx, lane = tid & 63, wr = wid >> 2, wc = wid & 3, fr = lane & 15, fq = lane >> 4;
    int offA[2], offB[2];
#pragma unroll
    for (int i = 0; i < 2; ++i) { int R, C; stage_rc(tid * 16 + i * 8192, R, C); const int rho = R & 31, Rb = PERM ? ((R & ~31) + 8 * ((rho & 15) >> 2) + 4 * (rho >> 4) + (rho & 3)) : R; offA[i] = R * lda + C; offB[i] = Rb * ldb + C; }
    const int aoff = lds_byte(wr * 64 + fr, fq * 8), boff = lds_byte(wc * 32 + fr, fq * 8);
    acc_t acc;
#pragma unroll
    for (int a = 0; a < 2; ++a)
#pragma unroll
        for (int b = 0; b < 2; ++b)
#pragma unroll
            for (int m = 0; m < 4; ++m)
#pragma unroll
                for (int n = 0; n < 2; ++n) acc[a][b][m][n] = (f32x4){0.f, 0.f, 0.f, 0.f};
    bf16x8 At[4][2], B0[2][2], B1[2][2];
    const int nt = K / BK;
    STAGE_B(SB(0, 0), bcol, 0); STAGE_A(SA(0, 0), brow, 0);
    STAGE_B(SB(0, 1), bcol + HALF, 0); STAGE_A(SA(0, 1), brow + HALF, 0);
    if (wr == 1) BAR;
    WAIT_V(4); BAR;
    STAGE_B(SB(1, 0), bcol, 1); STAGE_A(SA(1, 0), brow, 1); STAGE_B(SB(1, 1), bcol + HALF, 1);
    WAIT_V(6); BAR;
    for (int t = 0; t < nt - 2; t += 2) {
        if constexpr (DUAL) { if (t == 8) epi.mid(acc, brow, bcol, wr, wc, fr, fq); }
        LDB(B0, 0, 0); SCHED; LDA(At, 0, 0); STAGE_A(SA(1, 1), brow + HALF, t + 1);
        WAIT_L(8); BAR; WAIT_L(0); MMA(0, 0, At, B0); BAR; SCHED;
        LDB(B1, 0, 1); STAGE_B(SB(0, 0), bcol, t + 2);
        BAR; WAIT_L(0); MMA(0, 1, At, B1); BAR;
        LDA(At, 0, 1); STAGE_A(SA(0, 0), brow, t + 2);
        BAR; WAIT_L(0); MMA(1, 0, At, B0); BAR; SCHED;
        STAGE_B(SB(0, 1), bcol + HALF, t + 2);
        WAIT_V(6); BAR; MMA(1, 1, At, B1); BAR;
        LDB(B0, 1, 0); SCHED; LDA(At, 1, 0); STAGE_A(SA(0, 1), brow + HALF, t + 2);
        WAIT_L(8); BAR; WAIT_L(0); MMA(0, 0, At, B0); BAR; SCHED;
        LDB(B1, 1, 1); STAGE_B(SB(1, 0), bcol, t + 3);
        BAR; WAIT_L(0); MMA(0, 1, At, B1); BAR;
        LDA(At, 1, 1); STAGE_A(SA(1, 0), brow, t + 3);
        BAR; WAIT_L(0); MMA(1, 0, At, B0); BAR; SCHED;
        STAGE_B(SB(1, 1), bcol + HALF, t + 3);
        WAIT_V(6); BAR; MMA(1, 1, At, B1); BAR;
    }
    { LDB(B0, 0, 0); LDA(At, 0, 0); STAGE_A(SA(1, 1), brow + HALF, nt - 1);
      BAR; WAIT_L(0); MMA(0, 0, At, B0); BAR;
      LDB(B1, 0, 1); BAR; WAIT_L(0); MMA(0, 1, At, B1); BAR;
      LDA(At, 0, 1); WAIT_V(4); BAR; WAIT_L(0); MMA(1, 0, At, B0); MMA(1, 1, At, B1); BAR; }
    { LDB(B0, 1, 0); LDA(At, 1, 0); WAIT_V(2); BAR; WAIT_L(0); MMA(0, 0, At, B0); BAR;
      LDB(B1, 1, 1); WAIT_V(0); BAR; WAIT_L(0); MMA(0, 1, At, B1); BAR;
      LDA(At, 1, 1); BAR; WAIT_L(0); MMA(1, 0, At, B0); MMA(1, 1, At, B1); BAR; }
    if (wr == 0) BAR;
    { const int lane2 = opaque_tid(widx) & 63;
      epi(acc, brow, bcol, wr, wc, lane2 & 15, lane2 >> 4); }
    __syncthreads();
#undef SA
#undef SB
#undef STAGE_A
#undef STAGE_B
#undef LDA
#undef LDB
#undef MMA
}
#else
template <class Epi>
__device__ __forceinline__ void gemm_tile(unsigned char* shm, const bf16_t* __restrict__ A, int lda, const bf16_t* __restrict__ Bt, int ldb, int K, int brow, int bcol, const Epi& epi, int widx) {
    const int tid = opaque_tid(widx), wid = widx, lane = tid & 63, wr = wid >> 2, wc = wid & 3, fr = lane & 15, fq = lane >> 4;
    acc_t acc;
#pragma unroll
    for (int a = 0; a < 2; ++a)
#pragma unroll
        for (int b = 0; b < 2; ++b)
#pragma unroll
            for (int m = 0; m < 4; ++m)
#pragma unroll
                for (int n = 0; n < 2; ++n) acc[a][b][m][n] = (f32x4){0.f, 0.f, 0.f, 0.f};
    for (int k = 0; k < K; ++k) {
        float av[2][4], bv[2][2][4];
#pragma unroll
        for (int ai = 0; ai < 2; ++ai)
#pragma unroll
            for (int m = 0; m < 4; ++m) av[ai][m] = bf2f(A[(size_t)(brow + ai * 128 + wr * 64 + m * 16 + fr) * lda + k]);
#pragma unroll
        for (int bj = 0; bj < 2; ++bj)
#pragma unroll
            for (int n = 0; n < 2; ++n)
#pragma unroll
                for (int j = 0; j < 4; ++j) bv[bj][n][j] = bf2f(Bt[(size_t)(bcol + bj * 128 + wc * 32 + n * 16 + fq * 4 + j) * ldb + k]);
#pragma unroll
        for (int ai = 0; ai < 2; ++ai)
#pragma unroll
            for (int bj = 0; bj < 2; ++bj)
#pragma unroll
                for (int m = 0; m < 4; ++m)
#pragma unroll
                    for (int n = 0; n < 2; ++n)
#pragma unroll
                        for (int j = 0; j < 4; ++j) acc[ai][bj][m][n][j] += av[ai][m] * bv[bj][n][j];
    }
    epi(acc, brow, bcol, wr, wc, fr, fq);
}
#endif

__device__ __forceinline__ bool tile_of(int L, int nM, int nN, int& pm, int& pn) {
    const int nwg = nM * nN; if (L >= nwg) return false;
    int wgid = L; { const int q = nwg / 8, r = nwg % 8, xcd = wgid % 8, off = wgid / 8; wgid = (xcd < r ? xcd * (q + 1) : r * (q + 1) + (xcd - r) * q) + off; }
    const int nig = 8 * nN, gid = wgid / nig, fm = gid * 8, gsz = (nM - fm) < 8 ? (nM - fm) : 8;
    pm = fm + ((wgid % nig) % gsz); pn = (wgid % nig) / gsz; return true;
}


#if !NAIVE_GEMM
template <class Epi, bool AFTER_DRAIN = false, bool DUAL = false, long A2OFF = 0, long B2OFF = 0, bool PERM = false>
__device__ __forceinline__ void gemm_stream(unsigned char* shm, const bf16_t* __restrict__ A, int lda, const bf16_t* __restrict__ Bt, int ldb, int K, int nN, const Epi& epi, int widx) {
    const int tid = opaque_tid(widx), wid = widx, lane = tid & 63, wr = wid >> 2, wc = wid & 3, fr = lane & 15, fq = lane >> 4;
    const int nt = K / BK, nM = T / 256;
    unsigned voffA[2], voffB[2];
#pragma unroll
    for (int i = 0; i < 2; ++i) { int R, C; stage_rc(tid * 16 + i * 8192, R, C);
        const int rho = R & 31, Rb = PERM ? ((R & ~31) + 8 * ((rho & 15) >> 2) + 4 * (rho >> 4) + (rho & 3)) : R;
        voffA[i] = (unsigned)(R * lda + C) * 2u; voffB[i] = (unsigned)(Rb * ldb + C) * 2u; }
    const size_t kstep = (size_t)(BK * 2), hstepA = (size_t)HALF * lda * 2, hstepB = (size_t)HALF * ldb * 2, tstepA = 2 * hstepA, tstepB = 2 * hstepB;
#define GS_SA(b, h) (((b) * 2 + (h)) * HTB)
#define GS_SB(b, h) ((4 + (b) * 2 + (h)) * HTB)
#define GS_STAGE(bufoff, gbase, voff) do { _Pragma("unroll") for (int _i = 0; _i < 2; ++_i) { unsigned _vo = (voff)[_i]; asm volatile("" : "+v"(_vo));   \
        __builtin_amdgcn_global_load_lds((const unsigned*)((const char*)(gbase) + _vo), (unsigned*)(shm + (bufoff) + wid * 1024 + _i * 8192), 16, 0, 0); } } while (0)
#define GS_LDA(dst, b, h) do { _Pragma("unroll") for (int m = 0; m < 4; ++m) _Pragma("unroll") for (int k = 0; k < 2; ++k) dst[m][k] = *reinterpret_cast<const bf16x8*>(shm + GS_SA(b, h) + aoff + m * 2048 + k * 1024); } while (0)
#define GS_LDB(dst, b, h) do { _Pragma("unroll") for (int n = 0; n < 2; ++n) _Pragma("unroll") for (int k = 0; k < 2; ++k) dst[n][k] = *reinterpret_cast<const bf16x8*>(shm + GS_SB(b, h) + boff + n * 2048 + k * 1024); } while (0)
#define GS_MMA(ai, bj, At_, Bt_) do { __builtin_amdgcn_s_setprio(1); _Pragma("unroll") for (int m = 0; m < 4; ++m) _Pragma("unroll") for (int n = 0; n < 2; ++n) _Pragma("unroll") for (int k = 0; k < 2; ++k) \
        acc[ai][bj][m][n] = __builtin_amdgcn_mfma_f32_16x16x32_bf16(Bt_[n][k], At_[m][k], acc[ai][bj][m][n], 0, 0, 0); __builtin_amdgcn_s_setprio(0); } while (0)
    int pm, pn; int bxo = blockIdx.x; asm volatile("" : "+s"(bxo));
    if (!tile_of(bxo, nM, nN, pm, pn)) return;
    acc_t acc;
#pragma unroll
    for (int a = 0; a < 2; ++a)
#pragma unroll
        for (int b = 0; b < 2; ++b)
#pragma unroll
            for (int m = 0; m < 4; ++m)
#pragma unroll
                for (int n = 0; n < 2; ++n) acc[a][b][m][n] = (f32x4){0.f, 0.f, 0.f, 0.f};
    bf16x8 At[4][2], B0[2][2], B1[2][2];
    const char* cA = (const char*)A + (size_t)pm * tstepA; const char* cB = (const char*)Bt + (size_t)pn * tstepB;
    GS_STAGE(GS_SB(0, 0), cB, voffB); GS_STAGE(GS_SB(0, 1), cB + hstepB, voffB); GS_STAGE(GS_SA(0, 0), cA, voffA); GS_STAGE(GS_SA(0, 1), cA + hstepA, voffA);
    if (wr == 1) BAR;
    WAIT_V(2); BAR;
    GS_STAGE(GS_SB(1, 0), cB + kstep, voffB); GS_STAGE(GS_SA(1, 0), cA + kstep, voffA); GS_STAGE(GS_SB(1, 1), cB + hstepB + kstep, voffB);
    WAIT_V(6); BAR;
    const int aoff = lds_byte(wr * 64 + fr, fq * 8), boff = lds_byte(wc * 32 + fr, fq * 8);
    for (int ui = 0;; ++ui) {
        int pm2 = 0, pn2 = 0; const bool has_next = AFTER_DRAIN ? false : tile_of((ui + 1) * gridDim.x + bxo, nM, nN, pm2, pn2);
        const char* nA = has_next ? (const char*)A + (size_t)pm2 * tstepA : cA; const char* nB = has_next ? (const char*)Bt + (size_t)pn2 * tstepB : cB;
        for (int t = 0; t < nt; t += 2) {
            const bool last = (t == nt - 2);
            if constexpr (DUAL) { if (t == 8) { const int lane2 = opaque_tid(widx) & 63; epi.mid(acc, pm * 256, pn * 256, wr, wc, lane2 & 15, lane2 >> 4); } }
            const long da = (DUAL && t + 1 >= 8) ? (A2OFF * 2 - 8 * (long)kstep) : 0, da2 = (DUAL && t + 2 >= 8) ? (A2OFF * 2 - 8 * (long)kstep) : 0, db2 = (DUAL && t + 2 >= 8) ? (B2OFF * 2 - 8 * (long)kstep) : 0;
            const char* a1 = cA + (size_t)(t + 1) * kstep + da;
            const char* a2 = last ? nA : cA + (size_t)(t + 2) * kstep + da2; const char* b2 = last ? nB : cB + (size_t)(t + 2) * kstep + db2;
            const char* a3 = a2 + kstep; const char* b3 = b2 + kstep;
            GS_LDB(B0, 0, 0); GS_LDB(B1, 0, 1); SCHED; GS_LDA(At, 0, 0); GS_STAGE(GS_SA(1, 1), a1 + hstepA, voffA);
            WAIT_V(8); WAIT_L(0); BAR; GS_MMA(0, 0, At, B0); GS_MMA(0, 1, At, B1); BAR; SCHED;
            GS_LDA(At, 0, 1); GS_STAGE(GS_SB(0, 0), b2, voffB); GS_STAGE(GS_SB(0, 1), b2 + hstepB, voffB); GS_STAGE(GS_SA(0, 0), a2, voffA);
            WAIT_V(8); WAIT_L(0); BAR; GS_MMA(1, 0, At, B0); GS_MMA(1, 1, At, B1); BAR; SCHED;
            GS_LDB(B0, 1, 0); GS_LDB(B1, 1, 1); SCHED; GS_LDA(At, 1, 0); GS_STAGE(GS_SA(0, 1), a2 + hstepA, voffA);
            WAIT_V(8); WAIT_L(0); BAR; GS_MMA(0, 0, At, B0); GS_MMA(0, 1, At, B1); BAR; SCHED;
            GS_LDA(At, 1, 1); GS_STAGE(GS_SB(1, 0), b3, voffB); GS_STAGE(GS_SB(1, 1), b3 + hstepB, voffB); GS_STAGE(GS_SA(1, 0), a3, voffA);
            WAIT_V(8); WAIT_L(0); BAR; GS_MMA(1, 0, At, B0); GS_MMA(1, 1, At, B1); BAR; SCHED;
        }
        if (wr == 0) BAR;
        if (!AFTER_DRAIN) { const int lane2 = opaque_tid(widx) & 63; epi(acc, pm * 256, pn * 256, wr, wc, lane2 & 15, lane2 >> 4); }
        if (!has_next) break;
#pragma unroll
        for (int a = 0; a < 2; ++a)
#pragma unroll
            for (int b = 0; b < 2; ++b)
#pragma unroll
                for (int m = 0; m < 4; ++m)
#pragma unroll
                    for (int n = 0; n < 2; ++n) acc[a][b][m][n] = (f32x4){0.f, 0.f, 0.f, 0.f};
        pm = pm2; pn = pn2; cA = nA; cB = nB;
        if (wr == 1) BAR;
    }
    WAIT_V(0);
    BAR;
    __syncthreads();
    if (AFTER_DRAIN) { const int lane2 = opaque_tid(widx) & 63; epi(acc, pm * 256, pn * 256, wr, wc, lane2 & 15, lane2 >> 4); __syncthreads(); }
#undef GS_SA
#undef GS_SB
#undef GS_STAGE
#undef GS_LDA
#undef GS_LDB
#undef GS_MMA
}
#else
template <class Epi>
__device__ __forceinline__ void gemm_stream(unsigned char* shm, const bf16_t* __restrict__ A, int lda, const bf16_t* __restrict__ Bt, int ldb, int K, int nN, const Epi& epi, int widx) {
    for (int i = 0;; ++i) { int pm, pn; if (!tile_of(i * gridDim.x + blockIdx.x, T / 256, nN, pm, pn)) break; gemm_tile(shm, A, lda, Bt, ldb, K, pm * 256, pn * 256, epi, widx); }
}
#endif

#define EPI_ROWS _Pragma("unroll") for (int ai = 0; ai < 2; ++ai) _Pragma("unroll") for (int m = 0; m < 4; ++m)
#define EPI_COLS _Pragma("unroll") for (int bj = 0; bj < 2; ++bj) _Pragma("unroll") for (int n = 0; n < 2; ++n)
#define EPI_ROW (brow + ai * 128 + wr * 64 + m * 16 + fr)
#define EPI_COL (bcol + bj * 128 + wc * 32 + n * 16 + fq * 4)

struct EpiInproj {
    bf16_t *ZA, *GA, *GB;
    __device__ __forceinline__ void operator()(const acc_t& acc, int brow, int bcol, int wr, int wc, int fr, int fq) const {
        EPI_ROWS { const size_t row = EPI_ROW;
            EPI_COLS { const int col = EPI_COL; const f32x4 v = acc[ai][bj][m][n]; u32x2 w; w.x = pk2(v[0], v[1]); w.y = pk2(v[2], v[3]);
                if (col < 1184) *(u32x2*)(ZA + row * ZA_LD + col) = w;
                else if (col < 2208) *(u32x2*)(GA + row * 1024 + (col - 1184)) = w;
                else if (col < 3232) *(u32x2*)(GB + row * 1024 + (col - 2208)) = w; } }
    }
};
struct EpiInprojP {
    bf16_t *ZA, *GA, *GB;
    __device__ __forceinline__ void operator()(const acc_t& acc, int brow, int bcol, int wr, int wc, int fr, int fq) const {
        EPI_ROWS { const size_t row = EPI_ROW;
#pragma unroll
            for (int bj = 0; bj < 2; ++bj) { const int col = bcol + bj * 128 + wc * 32 + 8 * fq; const f32x4 v0 = acc[ai][bj][m][0], v1 = acc[ai][bj][m][1];
                u32x4 w; w.x = pk2(v0[0], v0[1]); w.y = pk2(v0[2], v0[3]); w.z = pk2(v1[0], v1[1]); w.w = pk2(v1[2], v1[3]);
                if (col < 1184) *(u32x4*)(ZA + row * ZA_LD + col) = w;
                else if (col < 2208) *(u32x4*)(GA + row * 1024 + (col - 1184)) = w;
                else if (col < 3232) *(u32x4*)(GB + row * 1024 + (col - 2208)) = w; } }
    }
};
struct EpiFF1P {
    bf16_t* F;
    __device__ __forceinline__ void operator()(const acc_t& acc, int brow, int bcol, int wr, int wc, int fr, int fq) const {
        EPI_ROWS { const size_t row = EPI_ROW;
#pragma unroll
            for (int bj = 0; bj < 2; ++bj) { const int col = bcol + bj * 128 + wc * 32 + 8 * fq; f32x4 v0 = acc[ai][bj][m][0], v1 = acc[ai][bj][m][1];
#pragma unroll
                for (int j = 0; j < 4; ++j) { const float r0 = fmaxf(v0[j], 0.f), r1 = fmaxf(v1[j], 0.f); v0[j] = r0 * r0; v1[j] = r1 * r1; }
                u32x4 w; w.x = pk2(v0[0], v0[1]); w.y = pk2(v0[2], v0[3]); w.z = pk2(v1[0], v1[1]); w.w = pk2(v1[2], v1[3]);
                *(u32x4*)(F + row * DFF + col) = w; } }
    }
};
struct EpiPoolP {
    bf16_t* AB; const float* scale;
    __device__ __forceinline__ void operator()(const acc_t& acc, int brow, int bcol, int wr, int wc, int fr, int fq) const {
        f32x4 sc0[2], sc1[2];
#pragma unroll
        for (int bj = 0; bj < 2; ++bj) { const int col = bcol + bj * 128 + wc * 32 + 8 * fq; sc0[bj] = *(const f32x4*)(scale + col); sc1[bj] = *(const f32x4*)(scale + col + 4); }
        EPI_ROWS { const size_t row = EPI_ROW;
#pragma unroll
            for (int bj = 0; bj < 2; ++bj) { const int col = bcol + bj * 128 + wc * 32 + 8 * fq; const f32x4 v0 = acc[ai][bj][m][0] * sc0[bj], v1 = acc[ai][bj][m][1] * sc1[bj];
                u32x4 w; w.x = pk2(v0[0], v0[1]); w.y = pk2(v0[2], v0[3]); w.z = pk2(v1[0], v1[1]); w.w = pk2(v1[2], v1[3]); *(u32x4*)(AB + row * 1024 + col) = w; } }
    }
};
struct EpiKP {
    bf16_t* Kk; const float* rstd;
    __device__ __forceinline__ void operator()(const acc_t& acc, int brow, int bcol, int wr, int wc, int fr, int fq) const {
        EPI_ROWS { const size_t row = EPI_ROW; const float rs = rstd[row];
#pragma unroll
            for (int bj = 0; bj < 2; ++bj) { const int col = bcol + bj * 128 + wc * 32 + 8 * fq; const f32x4 v0 = acc[ai][bj][m][0] * rs, v1 = acc[ai][bj][m][1] * rs;
                u32x4 w; w.x = pk2(v0[0], v0[1]); w.y = pk2(v0[2], v0[3]); w.z = pk2(v1[0], v1[1]); w.w = pk2(v1[2], v1[3]);
                *(u32x4*)(Kk + row * 768 + (col >> 6) * 96 + (col & 63)) = w; } }
    }
};
struct EpiPool {
    bf16_t* AB; const float* scale;
    __device__ __forceinline__ void operator()(const acc_t& acc, int brow, int bcol, int wr, int wc, int fr, int fq) const {
        EPI_ROWS { const size_t row = EPI_ROW;
            EPI_COLS { const int col = EPI_COL; const f32x4 v = acc[ai][bj][m][n] * *(const f32x4*)(scale + col); u32x2 w; w.x = pk2(v[0], v[1]); w.y = pk2(v[2], v[3]);
                *(u32x2*)(AB + row * 1024 + col) = w; } }
    }
};
struct EpiQ {
    bf16_t* Q; const float *rstd, *cs, *sn;
    __device__ __forceinline__ void operator()(const acc_t& acc, int brow, int bcol, int wr, int wc, int fr, int fq) const {
        EPI_ROWS { const size_t row = EPI_ROW; const float rs = rstd[row] * QSCALE;
            const f32x4 c4 = *(const f32x4*)(cs + row * 16 + fq * 4), s4 = *(const f32x4*)(sn + row * 16 + fq * 4);
#pragma unroll
            for (int bj = 0; bj < 2; ++bj) { const int col0 = bcol + bj * 128 + wc * 32; f32x4 v0 = acc[ai][bj][m][0] * rs, v1 = acc[ai][bj][m][1] * rs;
                if (((col0 >> 5) % 3) == 2) { const f32x4 r0 = v0 * c4 - v1 * s4, r1 = v1 * c4 + v0 * s4; v0 = r0; v1 = r1; }
                u32x2 w; w.x = pk2(v0[0], v0[1]); w.y = pk2(v0[2], v0[3]); *(u32x2*)(Q + row * 768 + col0 + fq * 4) = w;
                w.x = pk2(v1[0], v1[1]); w.y = pk2(v1[2], v1[3]); *(u32x2*)(Q + row * 768 + col0 + 16 + fq * 4) = w; } }
    }
};
struct EpiKV {
    bf16_t *Kk, *Vt; const float* rstd;
    __device__ __forceinline__ void operator()(const acc_t& acc, int brow, int bcol, int wr, int wc, int fr, int fq) const {
        EPI_ROWS { const size_t row = EPI_ROW; const float rs = rstd[row];
            EPI_COLS { const int col = EPI_COL; const f32x4 v = acc[ai][bj][m][n] * rs;
                if (col < 512) { u32x2 w; w.x = pk2(v[0], v[1]); w.y = pk2(v[2], v[3]); *(u32x2*)(Kk + row * 768 + (col >> 6) * 96 + (col & 63)) = w; }
                else { const size_t bb = row >> 12, s0_ = row & 4095, s = (s0_ & ~(size_t)12) | ((s0_ & 4) << 1) | ((s0_ & 8) >> 1); bf16_t* vp = Vt + (bb * 512 + (col - 512)) * 4096 + s;
                    vp[0] = (bf16_t)f2bf(v[0]); vp[4096] = (bf16_t)f2bf(v[1]); vp[8192] = (bf16_t)f2bf(v[2]); vp[12288] = (bf16_t)f2bf(v[3]); } } }
    }
};
struct EpiMerge1 {
    float* TMP; const bf16_t* GA;
    __device__ __forceinline__ void operator()(const acc_t& acc, int brow, int bcol, int wr, int wc, int fr, int fq) const {
        EPI_ROWS { const size_t row = EPI_ROW;
            EPI_COLS { const int col = EPI_COL; const u32x2 g = *(const u32x2*)(GA + row * 1024 + col); const f32x4 v = acc[ai][bj][m][n];
                f32x4 o; o[0] = sigmoidf(bflo(g.x)) * v[0]; o[1] = sigmoidf(bfhi(g.x)) * v[1]; o[2] = sigmoidf(bflo(g.y)) * v[2]; o[3] = sigmoidf(bfhi(g.y)) * v[3];
                *(f32x4*)(TMP + row * 1024 + col) = o; } }
    }
};
struct EpiMerge2 {
    const float* TMP; const bf16_t* GB; bf16_t* MRG;
    __device__ __forceinline__ void operator()(const acc_t& acc, int brow, int bcol, int wr, int wc, int fr, int fq) const {
        EPI_ROWS { const size_t row = EPI_ROW;
            EPI_COLS { const int col = EPI_COL; const u32x2 g = *(const u32x2*)(GB + row * 1024 + col); const f32x4 v = acc[ai][bj][m][n]; const f32x4 t = *(const f32x4*)(TMP + row * 1024 + col);
                f32x4 o; o[0] = t[0] + sigmoidf(bflo(g.x)) * v[0]; o[1] = t[1] + sigmoidf(bfhi(g.x)) * v[1]; o[2] = t[2] + sigmoidf(bflo(g.y)) * v[2]; o[3] = t[3] + sigmoidf(bfhi(g.y)) * v[3];
                u32x2 w; w.x = pk2(o[0], o[1]); w.y = pk2(o[2], o[3]); *(u32x2*)(MRG + row * 1024 + col) = w; } }
    }
};
struct EpiMergeDual {
    const bf16_t *GA, *GB; bf16_t* MRG;
    static __device__ __forceinline__ float em(float g) { return __expf(-fminf(fmaxf(g, -30.f), 30.f)); }
    __device__ __forceinline__ void mid(acc_t& acc, int brow, int bcol, int wr, int wc, int fr, int fq) const {
        asm volatile("" : "+v"(fr), "+v"(fq));
        EPI_ROWS { const size_t row = EPI_ROW;
            EPI_COLS { const int col = EPI_COL; const u32x2 ga = *(const u32x2*)(GA + row * 1024 + col), gb = *(const u32x2*)(GB + row * 1024 + col);
                f32x4 r; r[0] = (1.f + em(bflo(gb.x))) * __builtin_amdgcn_rcpf(1.f + em(bflo(ga.x))); r[1] = (1.f + em(bfhi(gb.x))) * __builtin_amdgcn_rcpf(1.f + em(bfhi(ga.x)));
                r[2] = (1.f + em(bflo(gb.y))) * __builtin_amdgcn_rcpf(1.f + em(bflo(ga.y))); r[3] = (1.f + em(bfhi(gb.y))) * __builtin_amdgcn_rcpf(1.f + em(bfhi(ga.y)));
                acc[ai][bj][m][n] *= r; }
            asm volatile("" ::: "memory"); }
    }
    __device__ __forceinline__ void operator()(const acc_t& acc, int brow, int bcol, int wr, int wc, int fr, int fq) const {
        EPI_ROWS { const size_t row = EPI_ROW;
            EPI_COLS { const int col = EPI_COL; const u32x2 gb = *(const u32x2*)(GB + row * 1024 + col); const f32x4 v = acc[ai][bj][m][n];
                f32x4 o; o[0] = v[0] * __builtin_amdgcn_rcpf(1.f + em(bflo(gb.x))); o[1] = v[1] * __builtin_amdgcn_rcpf(1.f + em(bfhi(gb.x)));
                o[2] = v[2] * __builtin_amdgcn_rcpf(1.f + em(bflo(gb.y))); o[3] = v[3] * __builtin_amdgcn_rcpf(1.f + em(bfhi(gb.y)));
                u32x2 w; w.x = pk2(o[0], o[1]); w.y = pk2(o[2], o[3]); *(u32x2*)(MRG + row * 1024 + col) = w; } }
    }
};
struct EpiMergeDualP {
    const bf16_t *GA, *GB; bf16_t* MRG;
    static __device__ __forceinline__ float em(float g) { return __expf(-fminf(fmaxf(g, -30.f), 30.f)); }
    static __device__ __forceinline__ float ratio(float gb, float ga) { return (1.f + em(gb)) * __builtin_amdgcn_rcpf(1.f + em(ga)); }
    __device__ __forceinline__ void mid(acc_t& acc, int brow, int bcol, int wr, int wc, int fr, int fq) const {
        asm volatile("" : "+v"(fr), "+v"(fq));
#pragma unroll
        for (int ai = 0; ai < 2; ++ai) {
            u32x4 ga[4][2], gb[4][2];
#pragma unroll
            for (int m = 0; m < 4; ++m) { const size_t row = EPI_ROW;
#pragma unroll
                for (int bj = 0; bj < 2; ++bj) { const int col = bcol + bj * 128 + wc * 32 + 8 * fq; ga[m][bj] = __builtin_nontemporal_load((const u32x4*)(GA + row * 1024 + col)); gb[m][bj] = *(const u32x4*)(GB + row * 1024 + col); } }
#pragma unroll
            for (int m = 0; m < 4; ++m)
#pragma unroll
                for (int bj = 0; bj < 2; ++bj) { const u32x4 a = ga[m][bj], b = gb[m][bj];
                    f32x4 r0, r1; r0[0] = ratio(bflo(b.x), bflo(a.x)); r0[1] = ratio(bfhi(b.x), bfhi(a.x)); r0[2] = ratio(bflo(b.y), bflo(a.y)); r0[3] = ratio(bfhi(b.y), bfhi(a.y));
                    r1[0] = ratio(bflo(b.z), bflo(a.z)); r1[1] = ratio(bfhi(b.z), bfhi(a.z)); r1[2] = ratio(bflo(b.w), bflo(a.w)); r1[3] = ratio(bfhi(b.w), bfhi(a.w));
                    acc[ai][bj][m][0] *= r0; acc[ai][bj][m][1] *= r1; }
            asm volatile("" ::: "memory");
        }
    }
    static __device__ __forceinline__ float sg(float g) { return __builtin_amdgcn_rcpf(1.f + em(g)); }
    __device__ __forceinline__ void operator()(const acc_t& acc, int brow, int bcol, int wr, int wc, int fr, int fq) const {
        EPI_ROWS { const size_t row = EPI_ROW;
#pragma unroll
            for (int bj = 0; bj < 2; ++bj) { const int col = bcol + bj * 128 + wc * 32 + 8 * fq; const u32x4 b = __builtin_nontemporal_load((const u32x4*)(GB + row * 1024 + col)); const f32x4 v0 = acc[ai][bj][m][0], v1 = acc[ai][bj][m][1];
                u32x4 w; w.x = pk2(v0[0] * sg(bflo(b.x)), v0[1] * sg(bfhi(b.x))); w.y = pk2(v0[2] * sg(bflo(b.y)), v0[3] * sg(bfhi(b.y)));
                w.z = pk2(v1[0] * sg(bflo(b.z)), v1[1] * sg(bfhi(b.z))); w.w = pk2(v1[2] * sg(bflo(b.w)), v1[3] * sg(bfhi(b.w)));
                *(u32x4*)(MRG + row * 1024 + col) = w; } }
    }
};
struct EpiRes {
    const float* xin; float* xout; const float* gate;
    __device__ __forceinline__ void operator()(const acc_t& acc, int brow, int bcol, int wr, int wc, int fr, int fq) const {
        const float* gb = gate + (size_t)(brow >> 12) * NMOD;
        EPI_ROWS { const size_t row = EPI_ROW;
            EPI_COLS { const int col = EPI_COL; const f32x4 g = *(const f32x4*)(gb + col); const f32x4 xi = __builtin_nontemporal_load((const f32x4*)(xin + row * 1024 + col));
                *(f32x4*)(xout + row * 1024 + col) = xi + g * acc[ai][bj][m][n]; } }
    }
};
template <int MODE, bool PL = false> struct EpiResNorm {
    const float* xin; float* xout; const float* gate; const float* ng; const float* nshift; const float* nscale; bf16_t* H; float* slots; unsigned* cnt; unsigned char* lds; int widx;
    __device__ __forceinline__ void operator()(acc_t& acc, int brow, int bcol, int wr, int wc, int fr, int fq) const {
        const int b = brow >> 12, pm = brow >> 8, pn = bcol >> 8;
        const float* gb = gate + (size_t)b * NMOD;
        float* P = (float*)lds; float* S = (float*)(lds + 4096);
        const int lane = fq * 16 + fr;
        EPI_ROWS { const size_t row = EPI_ROW; float sq = 0.f;
            EPI_COLS { const int col = PL ? (bcol + bj * 128 + wc * 32 + fq * 8 + n * 4) : EPI_COL; const f32x4 g = *(const f32x4*)(gb + col); const f32x4 xi = *(const f32x4*)(xin + row * 1024 + col);
                const f32x4 v = xi + g * acc[ai][bj][m][n]; acc[ai][bj][m][n] = v; sq += (v[0] * v[0] + v[1] * v[1]) + (v[2] * v[2] + v[3] * v[3]); }
            sq += __shfl_xor(sq, 16); sq += __shfl_xor(sq, 32);
            if (fq == 0) P[(ai * 128 + wr * 64 + m * 16 + fr) * 4 + wc] = sq; }
        __syncthreads();
        if (widx < 4) {
            const int r = widx * 64 + lane; const f32x4 pp = *(const f32x4*)(P + r * 4);
            __hip_atomic_store(slots + ((size_t)(brow + r) * 4 + pn), (pp[0] + pp[1]) + (pp[2] + pp[3]), __ATOMIC_RELAXED, __HIP_MEMORY_SCOPE_AGENT);
            asm volatile("s_waitcnt vmcnt(0)" ::: "memory");
            if (lane == 0) __hip_atomic_fetch_add(cnt + 64 * pm, 1u, __ATOMIC_RELAXED, __HIP_MEMORY_SCOPE_AGENT);
        }
        if (widx == 0) {
            unsigned sp = 0;
            while ((unsigned)__builtin_amdgcn_readfirstlane((int)__hip_atomic_load(cnt + 64 * pm, __ATOMIC_RELAXED, __HIP_MEMORY_SCOPE_AGENT)) < 16u) { __builtin_amdgcn_s_sleep(2); if (++sp > (1u << 22)) break; }
            __builtin_amdgcn_fence(__ATOMIC_ACQUIRE, "agent");
        }
        asm volatile("s_waitcnt vmcnt(0) lgkmcnt(0)" ::: "memory");
        __syncthreads();
        if (widx < 4) {
            const int r = widx * 64 + lane; const float* sl = slots + (size_t)(brow + r) * 4; float t = 0.f;
#pragma unroll
            for (int q = 0; q < 4; ++q) t += __hip_atomic_load(sl + q, __ATOMIC_RELAXED, __HIP_MEMORY_SCOPE_AGENT);
            S[r] = rsqrtf(t * (1.0f / 1024.0f) + EPS);
        }
        __syncthreads();
        f32x4 gsv[2][2], shv[2][2];
#pragma unroll
        for (int bj = 0; bj < 2; ++bj)
#pragma unroll
            for (int n = 0; n < 2; ++n) { const int col = PL ? (bcol + bj * 128 + wc * 32 + fq * 8 + n * 4) : EPI_COL; const f32x4 g4 = *(const f32x4*)(ng + col);
                if (MODE == 0) { gsv[bj][n] = g4 * (*(const f32x4*)(nscale + (size_t)b * NMOD + col) + 1.0f); shv[bj][n] = *(const f32x4*)(nshift + (size_t)b * NMOD + col); }
                else { gsv[bj][n] = g4; shv[bj][n] = g4; } }
        EPI_ROWS { const size_t row = EPI_ROW; const float rs = S[ai * 128 + wr * 64 + m * 16 + fr];
#pragma unroll
            for (int bj = 0; bj < 2; ++bj) { u32x2 wh[2];
#pragma unroll
                for (int n = 0; n < 2; ++n) { const int col = PL ? (bcol + bj * 128 + wc * 32 + fq * 8 + n * 4) : EPI_COL; const f32x4 v = acc[ai][bj][m][n]; const f32x4 g4 = gsv[bj][n];
                    if (MODE == 0) { *(f32x4*)(xout + row * 1024 + col) = v;
                        const f32x4 o = v * rs * g4 + shv[bj][n]; wh[n].x = pk2(o[0], o[1]); wh[n].y = pk2(o[2], o[3]);
                        if (!PL) *(u32x2*)(H + row * 1024 + col) = wh[n]; }
                    else __builtin_nontemporal_store(v * rs * g4, (f32x4*)(xout + row * 1024 + col)); }
                if (MODE == 0 && PL) *(u32x4*)(H + row * 1024 + bcol + bj * 128 + wc * 32 + fq * 8) = (u32x4){wh[0].x, wh[0].y, wh[1].x, wh[1].y}; } }
        __syncthreads();
    }
};
struct EpiFF1 {
    bf16_t* F;
    __device__ __forceinline__ void operator()(const acc_t& acc, int brow, int bcol, int wr, int wc, int fr, int fq) const {
        EPI_ROWS { const size_t row = EPI_ROW;
            EPI_COLS { const int col = EPI_COL; f32x4 v = acc[ai][bj][m][n];
#pragma unroll
                for (int j = 0; j < 4; ++j) { const float r = fmaxf(v[j], 0.f); v[j] = r * r; }
                u32x2 w; w.x = pk2(v[0], v[1]); w.y = pk2(v[2], v[3]); *(u32x2*)(F + row * DFF + col) = w; } }
    }
};

__device__ __forceinline__ void transpose_item(const float* __restrict__ W, int ldw, bf16_t* __restrict__ WT, int ldt, int k0, int n0, int drow0, int dcol0, const float* kscale, float* scr, int lane) {
    {
        const int kb = lane >> 3, n4 = (lane & 7) * 4; f32x4 v[8];
#pragma unroll
        for (int i = 0; i < 8; ++i) v[i] = __builtin_nontemporal_load((const f32x4*)(W + (size_t)(k0 + kb + 8 * i) * ldw + n0 + n4));
#pragma unroll
        for (int i = 0; i < 8; ++i) { const int kk = kb + 8 * i; f32x4 t = v[i]; if (kscale) t = t * kscale[k0 + kk];
            float* d = scr + kk * 33 + n4; d[0] = t[0]; d[1] = t[1]; d[2] = t[2]; d[3] = t[3]; }
    }
    LDS_WAIT(); asm volatile("" ::: "memory");
    const int c = lane & 7;
#pragma unroll
    for (int j = 0; j < 4; ++j) { const int n = (lane >> 3) + 8 * j; const float* s = scr + (8 * c) * 33 + n;
        u32x4 o; o.x = pk2(s[0 * 33], s[1 * 33]); o.y = pk2(s[2 * 33], s[3 * 33]); o.z = pk2(s[4 * 33], s[5 * 33]); o.w = pk2(s[6 * 33], s[7 * 33]);
        *(u32x4*)(WT + (size_t)(drow0 + n0 + n) * ldt + dcol0 + k0 + 8 * c) = o; }
    LDS_WAIT(); asm volatile("" ::: "memory");
}

__device__ __forceinline__ void convert_weights(const Params& p, int l, unsigned char* shm) {
    const int widx = p.widx;
    const int tid = opaque_tid(widx), wave = widx, lane = tid & 63;
    float* scr = (float*)(shm + wave * 16384);
    unsigned char* wb = p.ws + WS_W;
    const int gw = blockIdx.x * 8 + wave, NGW = gridDim.x * 8;
    constexpr int I_IN = 16 * 101, I_UQ = 6 * 24, I_UK = 4 * 16, I_UV = 4 * 16, I_POOL = 32, I_PA = 8 * 32, I_PB = 8 * 32, I_OUT = 16 * 32, I_FF1 = 16 * 128, I_FF2 = 64 * 32;
    constexpr int NITEMS = I_IN + I_UQ + I_UK + I_UV + I_POOL + I_PA + I_PB + I_OUT + I_FF1 + I_FF2;
    for (int it = gw; it < NITEMS; it += NGW) {
        int r = it;
        if (r < I_FF1) { transpose_item(p.w_ff1 + (size_t)l * 1024 * 4096, 4096, (bf16_t*)(wb + W_FF1), 1024, (r / 128) * 64, (r % 128) * 32, 0, 0, nullptr, scr, lane); continue; } r -= I_FF1;
        if (r < I_FF2) { transpose_item(p.w_ff2 + (size_t)l * 4096 * 1024, 1024, (bf16_t*)(wb + W_FF2), 4096, (r / 32) * 64, (r % 32) * 32, 0, 0, nullptr, scr, lane); continue; } r -= I_FF2;
        if (r < I_IN) { transpose_item(p.w_in + (size_t)l * 1024 * 3232, 3232, (bf16_t*)(wb + W_IN), 1024, (r / 101) * 64, (r % 101) * 32, 0, 0, nullptr, scr, lane); continue; } r -= I_IN;
        if (r < I_OUT) { transpose_item(p.w_out + (size_t)l * 1024 * 1024, 1024, (bf16_t*)(wb + W_OUT), 1024, (r / 32) * 64, (r % 32) * 32, 0, 0, nullptr, scr, lane); continue; } r -= I_OUT;
        if (r < I_PA) { transpose_item(p.p_pool + (size_t)l * 512 * 1024, 1024, (bf16_t*)(wb + W_PA), 512, (r / 32) * 64, (r % 32) * 32, 0, 0, nullptr, scr, lane); continue; } r -= I_PA;
        if (r < I_PB) { transpose_item(p.p_attn + (size_t)l * 512 * 1024, 1024, (bf16_t*)(wb + W_PB), 512, (r / 32) * 64, (r % 32) * 32, 0, 0, nullptr, scr, lane); continue; } r -= I_PB;
        if (r < I_UQ) { transpose_item(p.w_uq + (size_t)l * 384 * 768, 768, (bf16_t*)(wb + W_UQ), 384, (r / 24) * 64, (r % 24) * 32, 0, 0, p.q_norm_g + l * 384, scr, lane); continue; } r -= I_UQ;
        if (r < I_UK) { transpose_item(p.w_uk + (size_t)l * 256 * 512, 512, (bf16_t*)(wb + W_UKV), 256, (r / 16) * 64, (r % 16) * 32, 0, 0, p.kv_norm_g + l * 256, scr, lane); continue; } r -= I_UK;
        if (r < I_UV) { transpose_item(p.w_uv + (size_t)l * 256 * 512, 512, (bf16_t*)(wb + W_UKV), 256, (r / 16) * 64, (r % 16) * 32, 512, 0, p.kv_norm_g + l * 256, scr, lane); continue; } r -= I_UV;
        { const int g = r / 8, q = r % 8;
          transpose_item(p.w_pool + ((size_t)l * 4 + g) * 128 * 128, 128, (bf16_t*)(wb + W_POOL), 512, (q / 4) * 64, (q % 4) * 32, g * 128, g * 128, nullptr, scr, lane); }
    }
    const int gt = blockIdx.x * 512 + tid, NGT = gridDim.x * 512;
    unsigned zz = 0u; asm volatile("" : "+v"(zz)); const u32x4 z4 = {zz, zz, zz, zz};
    for (int i = gt; i < 96 * 1024 / 8; i += NGT) *(u32x4*)((bf16_t*)(wb + W_IN) + (size_t)3232 * 1024 + (size_t)i * 8) = z4;
    for (int i = gt; i < 512 * 512 / 8; i += NGT) { const int row = i / 64, col = (i % 64) * 8; if ((row >> 7) != (col >> 7)) *(u32x4*)((bf16_t*)(wb + W_POOL) + (size_t)row * 512 + col) = z4; }
}

__device__ __forceinline__ void phase_mod_partials(const Params& p, unsigned char* shm) {
    const int widx = p.widx;
    const int tid = opaque_tid(widx), wave = widx, lane = tid & 63;
    float* MODP = (float*)(p.ws + WS_MODP);
    float* cact = (float*)shm;
    __syncthreads();
#pragma unroll
    for (int q = 0; q < 8; ++q) { const float cv = p.c[tid + 512 * q]; cact[tid + 512 * q] = cv * sigmoidf(cv); }
    __syncthreads();
    const int NGW = gridDim.x * 8;
    for (int u = wave * gridDim.x + blockIdx.x; u < 2 * 96 * 8; u += NGW) {
        const int l = u / 768, r = u % 768, cgp = r / 8, kc = r % 8, col = cgp * 64 + lane;
        const float* w = p.w_ada + ((size_t)l * 1024 + kc * 128) * NMOD + col;
        float a0 = 0.f, a1 = 0.f, a2 = 0.f, a3 = 0.f;
#pragma unroll 1
        for (int k0 = 0; k0 < 128; k0 += 32) {
            float wv[32];
#pragma unroll
            for (int k = 0; k < 32; ++k) wv[k] = __builtin_nontemporal_load(w + (size_t)(k0 + k) * NMOD);
#pragma unroll
            for (int k = 0; k < 32; ++k) { const int kk = kc * 128 + k0 + k;
                a0 += cact[kk] * wv[k]; a1 += cact[1024 + kk] * wv[k]; a2 += cact[2048 + kk] * wv[k]; a3 += cact[3072 + kk] * wv[k]; }
        }
        float* o = MODP + ((size_t)(l * 8 + kc) * 4) * NMOD + col;
        o[0] = a0; o[NMOD] = a1; o[2 * NMOD] = a2; o[3 * NMOD] = a3;
    }
    float* COS = (float*)(p.ws + WS_COS); float* SIN = (float*)(p.ws + WS_SIN);
    const int gt = blockIdx.x * 512 + tid, NGT = gridDim.x * 512;
    for (int i = gt; i < T * 16; i += NGT) {
        const int t = i >> 4, k = i & 15;
        const float inv = powf(10000.0f, -(float)(2 * k) / 32.0f);
        const float ang = (float)p.pos[t] * inv;
        COS[i] = cosf(ang); SIN[i] = sinf(ang);
    }
}
__device__ __forceinline__ void phase_mod_final(const Params& p) {
    const int widx = p.widx;
    const float* MODP = (const float*)(p.ws + WS_MODP); float* MOD = (float*)(p.ws + WS_MOD);
    const int gt = blockIdx.x * 512 + opaque_tid(widx), NGT = gridDim.x * 512;
    for (int i = gt; i < 2 * 4 * NMOD; i += NGT) {
        const int l = i / (4 * NMOD), b = (i / NMOD) & 3, n = i % NMOD;
        float s = p.b_ada[l * NMOD + n];
#pragma unroll
        for (int kc = 0; kc < 8; ++kc) s += MODP[((size_t)(l * 8 + kc) * 4 + b) * NMOD + n];
        MOD[i] = s;
    }
}

__device__ __forceinline__ void phase_norm(const float* __restrict__ xin, const float* __restrict__ g, const float* __restrict__ shift, const float* __restrict__ scale  , bf16_t* __restrict__ H, int widx) {
    const int tid = opaque_tid(widx), wave = widx, lane = tid & 63;
    const int gw = blockIdx.x * 8 + wave, NGW = gridDim.x * 8;
    for (int r0 = gw * 8; r0 < T; r0 += NGW * 8) {
        const int b = r0 >> 12;
        f32x4 gs[4], sh[4];
#pragma unroll
        for (int j = 0; j < 4; ++j) { const int col = 4 * lane + 256 * j; gs[j] = *(const f32x4*)(g + col) * (*(const f32x4*)(scale + (size_t)b * NMOD + col) + 1.0f); sh[j] = *(const f32x4*)(shift + (size_t)b * NMOD + col); }
        for (int i = 0; i < 8; ++i) {
            const size_t row = r0 + i; f32x4 v[4]; float s = 0.f;
#pragma unroll
            for (int j = 0; j < 4; ++j) { v[j] = __builtin_nontemporal_load((const f32x4*)(xin + row * 1024 + 4 * lane + 256 * j)); s += (v[j][0] * v[j][0] + v[j][1] * v[j][1]) + (v[j][2] * v[j][2] + v[j][3] * v[j][3]); }
            const float rstd = rsqrtf(wave_sum(s) * (1.0f / 1024.0f) + EPS);
#pragma unroll
            for (int j = 0; j < 4; ++j) { const f32x4 o = v[j] * rstd * gs[j] + sh[j]; u32x2 w; w.x = pk2(o[0], o[1]); w.y = pk2(o[2], o[3]); *(u32x2*)(H + row * 1024 + 4 * lane + 256 * j) = w; }
        }
    }
}
__device__ __forceinline__ void phase_final_norm(float* __restrict__ x, const float* __restrict__ g, int widx) {
    const int tid = opaque_tid(widx), wave = widx, lane = tid & 63;
    const int gw = blockIdx.x * 8 + wave, NGW = gridDim.x * 8;
    f32x4 gs[4];
#pragma unroll
    for (int j = 0; j < 4; ++j) gs[j] = *(const f32x4*)(g + 4 * lane + 256 * j);
    for (int row = gw; row < T; row += NGW) {
        f32x4 v[4]; float s = 0.f;
#pragma unroll
        for (int j = 0; j < 4; ++j) { v[j] = *(const f32x4*)(x + (size_t)row * 1024 + 4 * lane + 256 * j); s += (v[j][0] * v[j][0] + v[j][1] * v[j][1]) + (v[j][2] * v[j][2] + v[j][3] * v[j][3]); }
        const float rstd = rsqrtf(wave_sum(s) * (1.0f / 1024.0f) + EPS);
#pragma unroll
        for (int j = 0; j < 4; ++j) *(f32x4*)(x + (size_t)row * 1024 + 4 * lane + 256 * j) = v[j] * rstd * gs[j];
    }
}

__device__ __forceinline__ void phase_prep(const Params& p, unsigned char* shm) {
    const int widx = p.widx;
    const int tid = opaque_tid(widx), wave = widx, lane = tid & 63;
    const bf16_t* ZA = (const bf16_t*)(p.ws + WS_ZA); bf16_t* P = (bf16_t*)(p.ws + WS_P); bf16_t* Kk = (bf16_t*)(p.ws + WS_K);
    float* RSQ = (float*)(p.ws + WS_RSQ); float* RSKV = (float*)(p.ws + WS_RSKV);
    const float* COS = (const float*)(p.ws + WS_COS); const float* SIN = (const float*)(p.ws + WS_SIN);
    unsigned* tile = (unsigned*)shm;
    for (int t0 = blockIdx.x * 64; t0 < T; t0 += gridDim.x * 64) {
        const int s0 = t0 & 4095;
        __syncthreads();
#pragma unroll
        for (int r = 0; r < 10; ++r) { const int i = tid + 512 * r, row = i >> 6, c8 = (i & 63) * 8;
            u32x4 v = {0u, 0u, 0u, 0u};
            if (s0 - 16 + row >= 0) v = *(const u32x4*)(ZA + (size_t)(t0 - 16 + row) * ZA_LD + c8);
            *(u32x4*)(tile + row * 256 + (c8 >> 1)) = v; }
        {
            const int i8 = lane >> 3, sub = lane & 7; const size_t t = t0 + wave * 8 + i8; const bf16_t* z = ZA + t * ZA_LD;
            u32x4 qv[6], kv[4];
#pragma unroll
            for (int r = 0; r < 6; ++r) qv[r] = *(const u32x4*)(z + ZC_Q + (sub + 8 * r) * 8);
#pragma unroll
            for (int r = 0; r < 4; ++r) kv[r] = *(const u32x4*)(z + ZC_KV + (sub + 8 * r) * 8);
            float sq = 0.f, sk = 0.f;
#pragma unroll
            for (int r = 0; r < 6; ++r)
#pragma unroll
                for (int e = 0; e < 4; ++e) { const float a = bflo(qv[r][e]), b = bfhi(qv[r][e]); sq += a * a + b * b; }
#pragma unroll
            for (int r = 0; r < 4; ++r)
#pragma unroll
                for (int e = 0; e < 4; ++e) { const float a = bflo(kv[r][e]), b = bfhi(kv[r][e]); sk += a * a + b * b; }
            sq += __shfl_xor(sq, 1); sq += __shfl_xor(sq, 2); sq += __shfl_xor(sq, 4);
            sk += __shfl_xor(sk, 1); sk += __shfl_xor(sk, 2); sk += __shfl_xor(sk, 4);
            if (sub == 0) { RSQ[t] = rsqrtf(sq * (1.0f / 384.0f) + EPS); RSKV[t] = rsqrtf(sk * (1.0f / 256.0f) + EPS); }
            {
                const u32x4 xa0 = *(const u32x4*)(z + ZC_KR), xa1 = *(const u32x4*)(z + ZC_KR + 8), xb0 = *(const u32x4*)(z + ZC_KR + 16), xb1 = *(const u32x4*)(z + ZC_KR + 24);
                f32x4 c4[4], s4[4];
#pragma unroll
                for (int q = 0; q < 4; ++q) { c4[q] = *(const f32x4*)(COS + t * 16 + 4 * q); s4[q] = *(const f32x4*)(SIN + t * 16 + 4 * q); }
                u32x4 lo0, lo1, hi0, hi1;
#define ROPE2(XA, XB, e, k) { const float c0 = c4[(k) >> 2][(k) & 3], c1 = c4[((k) + 1) >> 2][((k) + 1) & 3], n0 = s4[(k) >> 2][(k) & 3], n1 = s4[((k) + 1) >> 2][((k) + 1) & 3]; const float a0 = bflo(XA[e]), a1 = bfhi(XA[e]), b0 = bflo(XB[e]), b1 = bfhi(XB[e]); \
                              lo = pk2(a0 * c0 - b0 * n0, a1 * c1 - b1 * n1); hi = pk2(b0 * c0 + a0 * n0, b1 * c1 + a1 * n1); }
#pragma unroll
                for (int e = 0; e < 4; ++e) { unsigned lo, hi; ROPE2(xa0, xb0, e, 2 * e) lo0[e] = lo; hi0[e] = hi; }
#pragma unroll
                for (int e = 0; e < 4; ++e) { unsigned lo, hi; ROPE2(xa1, xb1, e, 8 + 2 * e) lo1[e] = lo; hi1[e] = hi; }
#undef ROPE2
                bf16_t* kd = Kk + t * 768 + sub * 96 + 64;
                *(u32x4*)(kd) = lo0; *(u32x4*)(kd + 8) = lo1; *(u32x4*)(kd + 16) = hi0; *(u32x4*)(kd + 24) = hi1;
            }
        }
        __syncthreads();
        {
            const int co = tid & 63, i0 = (tid >> 6) * 8, w = 2 << (co >> 4);
            float sm[8];
#pragma unroll
            for (int e = 0; e < 8; ++e) sm[e] = 0.f;
            for (int j = 1; j <= w; ++j) { const u32x4 v = *(const u32x4*)(tile + (16 + i0 - j) * 256 + co * 4);
#pragma unroll
                for (int e = 0; e < 4; ++e) { sm[2 * e] += bflo(v[e]); sm[2 * e + 1] += bfhi(v[e]); } }
#pragma unroll
            for (int i = 0; i < 8; ++i) {
                const u32x4 v = *(const u32x4*)(tile + (16 + i0 + i) * 256 + co * 4), o = *(const u32x4*)(tile + (16 + i0 + i - w) * 256 + co * 4);
                const int sidx = s0 + i0 + i; const float rc = 1.0f / (float)(sidx + 1 < w ? sidx + 1 : w);
                u32x4 ow;
#pragma unroll
                for (int e = 0; e < 4; ++e) { const float vl = bflo(v[e]), vh = bfhi(v[e]); sm[2 * e] += vl - bflo(o[e]); sm[2 * e + 1] += vh - bfhi(o[e]);
                    ow[e] = pk2(sm[2 * e] * rc - vl, sm[2 * e + 1] * rc - vh); }
                *(u32x4*)(P + (size_t)(t0 + i0 + i) * 512 + 8 * co) = ow;
            }
        }
    }
}

#if !NAIVE_ATTN
#define ATT_SCHED do {} while (0)
#define ATT_MFMA(a, b, c) __builtin_amdgcn_mfma_f32_32x32x16_bf16(a, b, c, 0, 0, 0)
#define ATT_WAIT_V(n) asm volatile("s_waitcnt vmcnt(" #n ")" ::: "memory")
#define ATT_BAR do { __builtin_amdgcn_s_barrier(); asm volatile("" ::: "memory"); } while (0)
constexpr int ATT_STAGE = 24576, ATT_VOFF = 16384;
template <bool MASK>
__device__ __forceinline__ void attn_unit(const unsigned char* kb, const unsigned char* vb, int xr, int g2, const bf16x8 (&qf)[6], f32x16& sc, f32x16& sn, f32x16& o0, f32x16& o1,
                                          float& mrow, float& lsum, int kbase, int qrow, int hh) {
#define KFRAG(s) (*(const bf16x8*)(kb + ((((2 * (s)) + hh) ^ xr) << 4)))
#define VFRAG(dt, st) (*(const bf16x8*)(vb + (((((dt) * 8) + g2 + 2 * (st)) ^ xr) << 4)))
    const f32x16 zero16 = {0.f, 0.f, 0.f, 0.f, 0.f, 0.f, 0.f, 0.f, 0.f, 0.f, 0.f, 0.f, 0.f, 0.f, 0.f, 0.f};
    bf16x8 ka = KFRAG(0), kaN;
    kaN = KFRAG(1);
    sn = ATT_MFMA(ka, qf[0], zero16);
    ka = KFRAG(2);
    sn = ATT_MFMA(kaN, qf[1], sn);
    if (MASK) {
#pragma unroll
        for (int i = 0; i < 16; ++i) { const int key = kbase + (i & 3) + 8 * (i >> 2) + 4 * hh; if (key > qrow) sc[i] = -1e30f; }
    }
    float mx = fmaxf(sc[0], sc[1]);
#pragma unroll
    for (int i = 2; i < 16; ++i) mx = fmaxf(mx, sc[i]);
    ATT_SCHED;
    kaN = KFRAG(3);
    sn = ATT_MFMA(ka, qf[2], sn);
    ka = KFRAG(4);
    sn = ATT_MFMA(kaN, qf[3], sn);
    mx = fmaxf(mx, __shfl_xor(mx, 32));
    const bool grow = mx > mrow + 8.0f;
    if (__builtin_amdgcn_ballot_w64(grow) != 0ull) {
        const float mref = grow ? mx : mrow, alpha = __builtin_amdgcn_exp2f(mrow - mref); mrow = mref;
        lsum *= alpha;
#pragma unroll
        for (int i = 0; i < 16; ++i) { o0[i] *= alpha; o1[i] *= alpha; }
    }
    const float mnew = mrow;
    float ps = 0.f;
#pragma unroll
    for (int i = 0; i < 8; ++i) { sc[i] = __builtin_amdgcn_exp2f(sc[i] - mnew); ps += sc[i]; }
    u32x4 w0; w0.x = pk2(sc[0], sc[1]); w0.y = pk2(sc[2], sc[3]); w0.z = pk2(sc[4], sc[5]); w0.w = pk2(sc[6], sc[7]);
    ATT_SCHED;
    kaN = KFRAG(5);
    sn = ATT_MFMA(ka, qf[4], sn);
    const bf16x8 va = VFRAG(0, 0), vc = VFRAG(1, 0), vb2 = VFRAG(0, 1), vd = VFRAG(1, 1);
    sn = ATT_MFMA(kaN, qf[5], sn);
#pragma unroll
    for (int i = 8; i < 16; ++i) { sc[i] = __builtin_amdgcn_exp2f(sc[i] - mnew); ps += sc[i]; }
    u32x4 w1; w1.x = pk2(sc[8], sc[9]); w1.y = pk2(sc[10], sc[11]); w1.z = pk2(sc[12], sc[13]); w1.w = pk2(sc[14], sc[15]);
    lsum += ps;
    ATT_SCHED;
    const bf16x8 p0 = __builtin_bit_cast(bf16x8, w0), p1 = __builtin_bit_cast(bf16x8, w1);
    o0 = ATT_MFMA(va, p0, o0);
    o1 = ATT_MFMA(vc, p0, o1);
    o0 = ATT_MFMA(vb2, p1, o0);
    o1 = ATT_MFMA(vd, p1, o1);
#undef KFRAG
#undef VFRAG
}

__device__ __forceinline__ void phase_attn(const Params& p, unsigned char* shm) {
    const int widx = p.widx;
    const bf16_t* Q = (const bf16_t*)(p.ws + WS_Q); const bf16_t* Kg = (const bf16_t*)(p.ws + WS_K); const bf16_t* Vt = (const bf16_t*)(p.ws + WS_VT); bf16_t* AB = (bf16_t*)(p.ws + WS_AB);
    const int tid = opaque_tid(widx), wave = widx, lane = tid & 63, r = lane & 31, hh = lane >> 5, xr = r & 15;
    int kgo[2], vgo;
#pragma unroll
    for (int _i = 0; _i < 2; ++_i) { const int R = 8 * wave + 4 * _i + (lane >> 4), L = (lane & 15) ^ (R & 15); kgo[_i] = R * 768 + (L < 12 ? L : 0) * 8; }
    { const int R = 4 * wave + (lane >> 4), C = (lane & 15) ^ (R & 15), d = R + 32 * (C >> 3), c = C & 7; vgo = d * 4096 + c * 8; }
#define ATT_ISSUE(t) do { unsigned char* _st = shm + ((t) % 6) * ATT_STAGE; const char* _kg = (const char*)(kbase_g + (size_t)(t) * 64 * 768); const char* _vg = (const char*)(vbase_g + (size_t)(t) * 64); \
        asm volatile("" : "+s"(_kg), "+s"(_vg));        \
        unsigned _k0 = (unsigned)kgo[0] * 2u, _k1 = (unsigned)kgo[1] * 2u, _v0 = (unsigned)vgo * 2u; asm volatile("" : "+v"(_k0), "+v"(_k1), "+v"(_v0));     \
        __builtin_amdgcn_global_load_lds((const unsigned*)(_kg + _k0), (unsigned*)(_st + wave * 2048), 16, 0, 0); \
        __builtin_amdgcn_global_load_lds((const unsigned*)(_kg + _k1), (unsigned*)(_st + wave * 2048 + 1024), 16, 0, 0); \
        __builtin_amdgcn_global_load_lds((const unsigned*)(_vg + _v0), (unsigned*)(_st + ATT_VOFF + wave * 1024), 16, 0, 0); } while (0)
    for (int u = blockIdx.x; u < 256; u += gridDim.x) {
        int gdx = gridDim.x; asm volatile("" : "+s"(gdx));
        const int uu = (gdx == 256) ? ((u & 7) * 32 + (u >> 3)) : u;
        const int b = uu >> 6, h = (uu >> 3) & 7, x = uu & 7;
        const bf16_t* kbase_g = Kg + (size_t)(b * 4096) * 768 + h * 96;
        const bf16_t* vbase_g = Vt + (size_t)(b * 512 + h * 64) * 4096;
        for (int half = 0; half < 2; ++half) {
            const int qb = half == 0 ? 15 - x : x, q0 = qb * 256, nkt = (q0 + 256) / 64;
            const int qrow = q0 + wave * 32 + r, qmax = q0 + wave * 32 + 31;
            const bf16_t* qp = Q + (size_t)(b * 4096 + qrow) * 768 + h * 96 + hh * 8;
            bf16x8 qf[6];
#pragma unroll
            for (int s = 0; s < 6; ++s) qf[s] = *(const bf16x8*)(qp + 16 * s);
            ATT_WAIT_V(0); __syncthreads();
            ATT_ISSUE(0); ATT_ISSUE(1); ATT_ISSUE(2); ATT_ISSUE(3);
            f32x16 o0, o1, sc, sd;
#pragma unroll
            for (int i = 0; i < 16; ++i) { o0[i] = 0.f; o1[i] = 0.f; sc[i] = 0.f; sd[i] = 0.f; }
            float mrow = -1e30f, lsum = 0.f;
            ATT_WAIT_V(0); ATT_BAR;
            {
                const unsigned char* kb = shm + r * 256;
#pragma unroll
                for (int s = 0; s < 6; ++s) { const bf16x8 ka = *(const bf16x8*)(kb + (((2 * s + hh) ^ xr) << 4)); sc = ATT_MFMA(ka, qf[s], sc); }
            }
#define ATT_PAIR_HEAD() \
                const int ta = 2 * it, k0 = ta * 64; \
                if (ta + 3 < nkt) asm volatile("s_waitcnt vmcnt(3) lgkmcnt(0)" ::: "memory"); else asm volatile("s_waitcnt vmcnt(0) lgkmcnt(0)" ::: "memory"); \
                ATT_BAR; \
                if (ta + 4 < nkt) ATT_ISSUE(ta + 4); \
                if (ta + 5 < nkt) ATT_ISSUE(ta + 5); \
                const unsigned char* sta = shm + (ta % 6) * ATT_STAGE + r * 256; \
                const unsigned char* stb = shm + ((ta + 1) % 6) * ATT_STAGE + r * 256; \
                const unsigned char* stc2 = shm + ((ta + 2) % 6) * ATT_STAGE + r * 256;
            int it = 0;
            for (; it < nkt / 2 - 2; ++it) {
                ATT_PAIR_HEAD()
                attn_unit<false>(sta + 32 * 256, sta + ATT_VOFF, xr, hh, qf, sc, sd, o0, o1, mrow, lsum, k0, qrow, hh);
                attn_unit<false>(stb, sta + ATT_VOFF, xr, 4 + hh, qf, sd, sc, o0, o1, mrow, lsum, k0 + 32, qrow, hh);
                attn_unit<false>(stb + 32 * 256, stb + ATT_VOFF, xr, hh, qf, sc, sd, o0, o1, mrow, lsum, k0 + 64, qrow, hh);
                attn_unit<false>(stc2, stb + ATT_VOFF, xr, 4 + hh, qf, sd, sc, o0, o1, mrow, lsum, k0 + 96, qrow, hh);
            }
            for (; it < nkt / 2; ++it) {
                ATT_PAIR_HEAD()
                if (k0 <= qmax) attn_unit<true>(sta + 32 * 256, sta + ATT_VOFF, xr, hh, qf, sc, sd, o0, o1, mrow, lsum, k0, qrow, hh);
                if (k0 + 32 <= qmax) attn_unit<true>(stb, sta + ATT_VOFF, xr, 4 + hh, qf, sd, sc, o0, o1, mrow, lsum, k0 + 32, qrow, hh);
                if (k0 + 64 <= qmax) attn_unit<true>(stb + 32 * 256, stb + ATT_VOFF, xr, hh, qf, sc, sd, o0, o1, mrow, lsum, k0 + 64, qrow, hh);
                if (k0 + 96 <= qmax) attn_unit<true>(stc2, stb + ATT_VOFF, xr, 4 + hh, qf, sd, sc, o0, o1, mrow, lsum, k0 + 96, qrow, hh);
            }
#undef ATT_PAIR_HEAD
            const float inv = 1.0f / (lsum + __shfl_xor(lsum, 32));
            bf16_t* op = AB + (size_t)(b * 4096 + qrow) * 1024 + 512 + h * 64 + 4 * hh;
#pragma unroll
            for (int g = 0; g < 4; ++g) { u32x2 w; w.x = pk2(o0[4 * g] * inv, o0[4 * g + 1] * inv); w.y = pk2(o0[4 * g + 2] * inv, o0[4 * g + 3] * inv); *(u32x2*)(op + 8 * g) = w;
                w.x = pk2(o1[4 * g] * inv, o1[4 * g + 1] * inv); w.y = pk2(o1[4 * g + 2] * inv, o1[4 * g + 3] * inv); *(u32x2*)(op + 32 + 8 * g) = w; }
        }
    }
#undef ATT_ISSUE
}
#else
__device__ __forceinline__ void phase_attn(const Params& p, unsigned char* shm) {
    const int widx = p.widx;
    const bf16_t* Q = (const bf16_t*)(p.ws + WS_Q); const bf16_t* Kg = (const bf16_t*)(p.ws + WS_K); const bf16_t* Vt = (const bf16_t*)(p.ws + WS_VT); bf16_t* AB = (bf16_t*)(p.ws + WS_AB);
    const int tid = opaque_tid(widx), wave = widx, lane = tid & 63;
    const int gw = blockIdx.x * 8 + wave, NGW = gridDim.x * 8;
    for (int u = gw; u < T * 8; u += NGW) {
        const int t = u >> 3, h = u & 7, b = t >> 12, s = t & 4095;
        const bf16_t* qp = Q + (size_t)t * 768 + h * 96;
        float m = -1e30f, l = 0.f, o = 0.f;
        for (int k0 = 0; k0 <= s; k0 += 64) {
            const int key = k0 + lane; float sc = -1e30f;
            if (key <= s) { const bf16_t* kp = Kg + (size_t)(b * 4096 + key) * 768 + h * 96; float a = 0.f; for (int d = 0; d < 96; ++d) a += bf2f(qp[d]) * bf2f(kp[d]); sc = a; }
            float mx = sc;
#pragma unroll
            for (int off = 1; off < 64; off <<= 1) mx = fmaxf(mx, __shfl_xor(mx, off));
            const float mnew = fmaxf(m, mx), alpha = exp2f(m - mnew); m = mnew;
            const float pr = exp2f(sc - mnew);
            l = l * alpha + wave_sum(pr); o *= alpha;
            for (int j = 0; j < 64; ++j) { const float pj = __shfl(pr, j); if (k0 + j <= s) { const int kj = k0 + j, kp = (kj & ~12) | ((kj & 4) << 1) | ((kj & 8) >> 1); o += pj * bf2f(Vt[(size_t)(b * 512 + h * 64 + lane) * 4096 + kp]); } }
        }
        AB[(size_t)t * 1024 + 512 + h * 64 + lane] = (bf16_t)f2bf(o / l);
    }
}
#endif

#define LAS __attribute__((address_space(3)))
#define XB_TMO      128
#define XB_XCNT(j)  (256  + 64 * (j))
#define XB_XSUB(j)  (1280 + 64 * (j))
#define XB_XGEN(j)  (2304 + 64 * (j))
#define XB_TOP      3328
#define XB_TOPGEN   3392
#define XCD_BAR_WORDS 3456
#define XB_SPIN_CAP (1u << 18)
__device__ __forceinline__ unsigned xb_ld(unsigned* p)              { return __hip_atomic_load(p, __ATOMIC_RELAXED, __HIP_MEMORY_SCOPE_AGENT); }
__device__ __forceinline__ unsigned xb_add(unsigned* p, unsigned v) { return __hip_atomic_fetch_add(p, v, __ATOMIC_RELAXED, __HIP_MEMORY_SCOPE_AGENT); }
__device__ __forceinline__ unsigned xb_xcc_id() { return (unsigned)__builtin_amdgcn_s_getreg((3 << 11) | 20) & 0xFu; }
#define XB_SPIN(cond, bar) do { unsigned _sp = 0; while (cond) { __builtin_amdgcn_s_sleep(1); \
    if ((++_sp & 255u) == 0u) { if (xb_ld(&(bar)[XB_TMO])) break; if (_sp > XB_SPIN_CAP) { atomicAdd(&(bar)[XB_TMO], 1u); break; } } } } while (0)
struct XcdBarrier { unsigned* bar; unsigned x; volatile LAS unsigned* st; };
__device__ __forceinline__ XcdBarrier xcd_barrier_post(unsigned* bar, volatile LAS unsigned* st) {
    XcdBarrier b; b.bar = bar; b.x = xb_xcc_id(); b.st = st;
    if (threadIdx.x == 0) (void)xb_add(&bar[XB_XCNT(b.x)], 1u);
    return b;
}
__device__ __forceinline__ void xcd_barrier_complete(unsigned* bar, unsigned x, unsigned& nloc, unsigned& nx) {
    const unsigned G = gridDim.x * gridDim.y * gridDim.z;
    unsigned sum, cnt, mine, sp = 0u;
    for (;;) {
        sum = 0u; cnt = 0u; mine = 0u;
#pragma unroll
        for (unsigned j = 0; j < 16; ++j) { const unsigned c = xb_ld(&bar[XB_XCNT(j)]); sum += c; cnt += (c > 0u) ? 1u : 0u; mine = (j == x) ? c : mine; }
        if (sum == G) break;
        __builtin_amdgcn_s_sleep(1);
        if ((++sp & 255u) == 0u) { if (xb_ld(&bar[XB_TMO])) break; if (sp > XB_SPIN_CAP) { atomicAdd(&bar[XB_TMO], 1u); break; } }
    }
    nloc = mine > 0u ? mine : 1u; nx = cnt > 0u ? cnt : 1u;
}
__device__ __forceinline__ void xcd_barrier(const XcdBarrier& b) {
    asm volatile("s_waitcnt vmcnt(0)" ::: "memory");
    __syncthreads();
    if (threadIdx.x == 0) {
        unsigned* bar = b.bar;
        __builtin_amdgcn_s_waitcnt(0);
        unsigned nloc = b.st[0], nx = b.st[1];
        if (nloc == 0u) { xcd_barrier_complete(bar, b.x, nloc, nx); b.st[0] = nloc; b.st[1] = nx; }
        const unsigned old = xb_add(&bar[XB_XSUB(b.x)], 1u);
        const unsigned gen = old / nloc;
        if (old + 1u == (gen + 1u) * nloc) {
            __builtin_amdgcn_fence(__ATOMIC_RELEASE, "agent");
            asm volatile("s_waitcnt vmcnt(0)" ::: "memory");
            const unsigned og = xb_add(&bar[XB_TOP], 1u);
            const unsigned tg = og / nx;
            if (og + 1u == (tg + 1u) * nx) xb_add(&bar[XB_TOPGEN], 1u);
            else XB_SPIN(xb_ld(&bar[XB_TOPGEN]) == tg, bar);
            __builtin_amdgcn_fence(__ATOMIC_ACQUIRE, "agent");
            xb_add(&bar[XB_XGEN(b.x)], 1u);
            asm volatile("s_waitcnt vmcnt(0)" ::: "memory");
        } else {
            XB_SPIN(xb_ld(&bar[XB_XGEN(b.x)]) == gen, bar);
            __builtin_amdgcn_fence(__ATOMIC_ACQUIRE, "agent");
            asm volatile("s_waitcnt vmcnt(0)" ::: "memory");
        }
    }
    __syncthreads();
}

template <class Epi>
__device__ __forceinline__ void gemm_phase(unsigned char* shm, const bf16_t* A, int lda, const bf16_t* Bt, int ldb, int K, int nN, const Epi& epi, int widx) {
    for (int i = 0;; ++i) { int pm, pn; if (!tile_of(i * gridDim.x + blockIdx.x, T / 256, nN, pm, pn)) break; gemm_tile(shm, A, lda, Bt, ldb, K, pm * 256, pn * 256, epi, widx); }
}

__global__ void __launch_bounds__(512, 2) fwd_kernel(Params pin) {
    extern __shared__ __attribute__((aligned(16))) unsigned char shm[];
    const int widx0 = __builtin_amdgcn_readfirstlane((int)(threadIdx.x >> 6));
    volatile LAS unsigned* bst = (volatile LAS unsigned*)(shm + 147456);
    if (threadIdx.x < 2) bst[threadIdx.x] = 0u;
    __syncthreads();
    XcdBarrier gbar = xcd_barrier_post((unsigned*)pin.ws, bst);
    int redone = 0;
    for (int ph = pin.ph_lo; ph < pin.ph_hi; ++ph) {
        if (ph >= 2 && ph < 22 && (ph - 2) % 10 == 7) continue;
        int widx = widx0; asm volatile("" : "+s"(widx));
#if defined(__HIP_DEVICE_COMPILE__)
        typedef const __attribute__((address_space(4))) Params* kparams_ptr;
        kparams_ptr kp = (kparams_ptr)__builtin_amdgcn_kernarg_segment_ptr(); asm volatile("" : "+s"(kp));
        Params p = *kp; p.widx = widx;
#else
        Params p = pin; p.widx = widx;
#endif
        {
            size_t z = 0; asm volatile("" : "+s"(z));
#define LAUNDER(f) p.f += z
            LAUNDER(x); LAUNDER(c); LAUNDER(pos); LAUNDER(ln1_g); LAUNDER(ln2_g); LAUNDER(w_ada); LAUNDER(b_ada); LAUNDER(w_in); LAUNDER(q_norm_g); LAUNDER(w_uq); LAUNDER(kv_norm_g);
            LAUNDER(w_uk); LAUNDER(w_uv); LAUNDER(w_pool); LAUNDER(pool_scale); LAUNDER(p_pool); LAUNDER(p_attn); LAUNDER(w_out); LAUNDER(w_ff1); LAUNDER(w_ff2); LAUNDER(final_g); LAUNDER(out); LAUNDER(ws);
#undef LAUNDER
        }
        unsigned char* ws = p.ws; unsigned char* wb = ws + WS_W;
        float* X = p.out;
        const float* MOD = (const float*)(ws + WS_MOD);
        if (ph == 0) { if (PEN(10)) phase_mod_partials(p, shm); }
        else if (ph == 1) { if (PEN(11)) phase_mod_final(p); }
        else {
            const int l = (ph - 2) / 10, k = (ph - 2) % 10;
            const float* mod = MOD + (size_t)l * 4 * NMOD;
            switch (k) {
            case 0: if (PEN(0)) convert_weights(p, l, shm);
                    if (l == 0) phase_norm(p.x, p.ln1_g, mod + 0, mod + 1024, (bf16_t*)(ws + WS_H), widx);
                    break;
            case 1: if (PEN(1)) { EpiInprojP e{(bf16_t*)(ws + WS_ZA), (bf16_t*)(ws + WS_GA), (bf16_t*)(ws + WS_GB)};
                    gemm_stream<EpiInprojP, false, false, 0, 0, true>(shm, (const bf16_t*)(ws + WS_H), 1024, (const bf16_t*)(wb + W_IN), 1024, 1024, 13, e, widx); } break;
            case 2: if (PEN(2)) phase_prep(p, shm); break;
            case 3: if (PEN(3)) {
                    int gdx = gridDim.x; asm volatile("" : "+s"(gdx)); const bool deal = (gdx == 256);
                    for (int i = 0;; ++i) { int kind, pm, pn;
                        if (deal) { const int bx = blockIdx.x; int c = -1, vt = -1;
                            if (bx < 192) { if (i == 0) { kind = 1; pm = bx / 3; pn = bx % 3; } else if (i == 1) { if (bx < 64) c = 192 + bx; else vt = bx - 64; } else break; }
                            else { if (i < 3) c = 3 * (bx - 192) + i; else break; }
                            if (c >= 0) { if (c < 128) { kind = 0; pm = c >> 1; pn = c & 1; } else { kind = 2; pm = (c - 128) >> 1; pn = (c - 128) & 1; } }
                            if (vt >= 0) { kind = 2; pm = vt >> 1; pn = 2 + (vt & 1); }
                        } else { int q; if (!tile_of(i * gridDim.x + blockIdx.x, T / 256, 9, pm, q)) break; if (q < 2) { kind = 0; pn = q; } else if (q < 5) { kind = 1; pn = q - 2; } else { kind = 2; pn = q - 5; } }
                        if (kind == 0) { EpiPoolP e{(bf16_t*)(ws + WS_AB), p.pool_scale + l * 512}; gemm_tile<EpiPoolP, false, 0, 0, true>(shm, (const bf16_t*)(ws + WS_P) + 256 * pn, 512, (const bf16_t*)(wb + W_POOL) + 256 * pn, 512, 256, pm * 256, pn * 256, e, widx); }
                        else if (kind == 1) { EpiQ e{(bf16_t*)(ws + WS_Q), (const float*)(ws + WS_RSQ), (const float*)(ws + WS_COS), (const float*)(ws + WS_SIN)};
                            gemm_tile(shm, (const bf16_t*)(ws + WS_ZA) + ZC_Q, ZA_LD, (const bf16_t*)(wb + W_UQ), 384, 384, pm * 256, pn * 256, e, widx); }
                        else if (pn < 2) { EpiKP e{(bf16_t*)(ws + WS_K), (const float*)(ws + WS_RSKV)};
                            gemm_tile<EpiKP, false, 0, 0, true>(shm, (const bf16_t*)(ws + WS_ZA) + ZC_KV, ZA_LD, (const bf16_t*)(wb + W_UKV), 256, 256, pm * 256, pn * 256, e, widx); }
                        else { EpiKV e{(bf16_t*)(ws + WS_K), (bf16_t*)(ws + WS_VT), (const float*)(ws + WS_RSKV)};
                            gemm_tile(shm, (const bf16_t*)(ws + WS_ZA) + ZC_KV, ZA_LD, (const bf16_t*)(wb + W_UKV), 256, 256, pm * 256, pn * 256, e, widx); } } } break;
            case 4: if (PEN(4)) phase_attn(p, shm); break;
            case 5: if (PEN(5)) { EpiMergeDualP e{(const bf16_t*)(ws + WS_GA), (const bf16_t*)(ws + WS_GB), (bf16_t*)(ws + WS_MRG)};
                    gemm_stream<EpiMergeDualP, false, true, 512, (long)((W_PB - W_PA) / 2), true>(shm, (const bf16_t*)(ws + WS_AB), 1024, (const bf16_t*)(wb + W_PA), 512, 1024, 4, e, widx); } break;
            case 6: if (PEN(6)) {
                    EpiResNorm<0, true> e{l == 0 ? p.x : X, X, mod + 2048, p.ln2_g + l * 1024, mod + 3072, mod + 4096, (bf16_t*)(ws + WS_H2),
                                    (float*)(ws + WS_SLOTS) + (size_t)(2 * l) * T * 4, (unsigned*)(ws + WS_CNT) + (size_t)(2 * l) * 64 * 64, shm, widx};
                    gemm_stream<EpiResNorm<0, true>, true, false, 0, 0, true>(shm, (const bf16_t*)(ws + WS_MRG), 1024, (const bf16_t*)(wb + W_OUT), 1024, 1024, 4, e, widx); } break;
            case 8: if (PEN(8)) { EpiFF1P e{(bf16_t*)(ws + WS_F)};
                    gemm_stream<EpiFF1P, false, false, 0, 0, true>(shm, (const bf16_t*)(ws + WS_H2), 1024, (const bf16_t*)(wb + W_FF1), 1024, 1024, 16, e, widx); } break;
            case 9: if (PEN(9)) {
                    const float* mod1 = MOD + (size_t)4 * NMOD;
                    float* sl = (float*)(ws + WS_SLOTS) + (size_t)(2 * l + 1) * T * 4; unsigned* cn = (unsigned*)(ws + WS_CNT) + (size_t)(2 * l + 1) * 64 * 64;
                    if (l == 0) { EpiResNorm<0, true> e{X, X, mod + 5120, p.ln1_g + 1024, mod1 + 0, mod1 + 1024, (bf16_t*)(ws + WS_H), sl, cn, shm, widx};
                        gemm_stream<EpiResNorm<0, true>, true, false, 0, 0, true>(shm, (const bf16_t*)(ws + WS_F), 4096, (const bf16_t*)(wb + W_FF2), 4096, 4096, 4, e, widx); }
                    else { EpiResNorm<1, true> e{X, X, mod + 5120, p.final_g, nullptr, nullptr, nullptr, sl, cn, shm, widx};
                        gemm_stream<EpiResNorm<1, true>, true, false, 0, 0, true>(shm, (const bf16_t*)(ws + WS_F), 4096, (const bf16_t*)(wb + W_FF2), 4096, 4096, 4, e, widx); } } break;
            }
        }
        if (ph + 1 < pin.ph_hi) {
#if CG_SYNC
            cg::this_grid().sync();
#else
            if (pin.ph_hi > 1000) cg::this_grid().sync();
            { XcdBarrier gb2 = gbar; asm volatile("" : "+s"(gb2.bar)); xcd_barrier(gb2); }
#endif
            if (PROBE_MASK != 0u) {
                const bool hit = ph >= 2 && ph < 22 && ((PROBE_MASK >> ((ph - 2) % 10)) & 1u);
                if (hit && !redone) { redone = 1; --ph; } else redone = 0;
            }
        }
    }
}

extern "C" void kernel_launch(void* const* d_in, const int* in_sizes, int n_in, void* d_out, int out_size, void* d_ws, size_t ws_size, hipStream_t stream) {
    static int grid = 0;
    if (grid == 0) {
        int dev = 0, cus = 0, per_cu = 0;
        hipGetDevice(&dev);
        hipDeviceGetAttribute(&cus, hipDeviceAttributeMultiprocessorCount, dev);
        hipFuncSetAttribute((const void*)fwd_kernel, hipFuncAttributeMaxDynamicSharedMemorySize, LDS_BYTES);
        hipOccupancyMaxActiveBlocksPerMultiprocessor(&per_cu, (const void*)fwd_kernel, 512, LDS_BYTES);
        if (per_cu < 1) { fprintf(stderr, "kernel_launch: occupancy query says %d blocks/CU\n", per_cu); per_cu = 1; }
        (void)hipGetLastError();
        grid = cus;
    }
    (void)hipMemsetAsync(d_ws, 0, CTL_ZERO_BYTES, stream);
    Params p{};
    p.x = (const float*)d_in[0]; p.c = (const float*)d_in[1]; p.pos = (const int*)d_in[2];
    p.ln1_g = (const float*)d_in[3]; p.ln2_g = (const float*)d_in[4]; p.w_ada = (const float*)d_in[5]; p.b_ada = (const float*)d_in[6];
    p.w_in = (const float*)d_in[7]; p.q_norm_g = (const float*)d_in[8]; p.w_uq = (const float*)d_in[9]; p.kv_norm_g = (const float*)d_in[10];
    p.w_uk = (const float*)d_in[11]; p.w_uv = (const float*)d_in[12]; p.w_pool = (const float*)d_in[13]; p.pool_scale = (const float*)d_in[14];
    p.p_pool = (const float*)d_in[15]; p.p_attn = (const float*)d_in[16]; p.w_out = (const float*)d_in[17]; p.w_ff1 = (const float*)d_in[18];
    p.w_ff2 = (const float*)d_in[19]; p.final_g = (const float*)d_in[20];
    p.out = (float*)d_out; p.ws = (unsigned char*)d_ws;
#if MULTI_LAUNCH
    for (int ph = 0; ph < 22; ++ph) { p.ph_lo = ph; p.ph_hi = ph + 1; hipLaunchKernelGGL(fwd_kernel, dim3(grid), dim3(512), LDS_BYTES, stream, p); }
#else
    p.ph_lo = 0; p.ph_hi = 22;
    void* args[] = {&p};
    hipError_t e = hipLaunchCooperativeKernel((const void*)fwd_kernel, dim3(grid), dim3(512), args, LDS_BYTES, stream);
    if (e != hipSuccess) fprintf(stderr, "cooperative launch failed: %s (grid %d)\n", hipGetErrorString(e), grid);
#endif
}
```

```cpp
#include <hip/hip_runtime.h>
#include <hip/hip_cooperative_groups.h>
#include <cstdio>
#include <cstdint>
namespace cg = cooperative_groups;

#ifndef NAIVE_GEMM
#define NAIVE_GEMM 0
#endif
#ifndef NAIVE_ATTN
#define NAIVE_ATTN 0
#endif
#ifndef PHASE_MASK
#define PHASE_MASK 0xFFFFFFu
#endif
#define PEN(k) ((PHASE_MASK >> (k)) & 1u)
#ifndef CG_SYNC
#define CG_SYNC 0
#endif
#ifndef PROBE_MASK
#define PROBE_MASK 0u
#endif
#ifndef MULTI_LAUNCH
#define MULTI_LAUNCH 0
#endif

typedef unsigned short bf16_t;
typedef short bf16x8 __attribute__((ext_vector_type(8)));
typedef float f32x4 __attribute__((ext_vector_type(4)));
typedef float f32x16 __attribute__((ext_vector_type(16)));
typedef unsigned u32x2 __attribute__((ext_vector_type(2)));
typedef unsigned u32x4 __attribute__((ext_vector_type(4)));

constexpr int T = 16384, D = 1024, SEQ = 4096, DFF = 4096;
constexpr int ZA_LD = 1184;
constexpr int ZC_Q = 512, ZC_KV = 896, ZC_KR = 1152;
constexpr int NMOD = 6144;
constexpr float EPS = 1e-6f;
constexpr float QSCALE = 0.10206207261596575f * 1.4426950408889634f;

constexpr size_t MiB = 1u << 20;
constexpr size_t WS_MODP = 1 * MiB;
constexpr size_t WS_MOD = 3 * MiB;
constexpr size_t WS_COS = 4 * MiB;
constexpr size_t WS_SIN = 5 * MiB;
constexpr size_t WS_RSQ = 6 * MiB;
constexpr size_t WS_RSKV = 6 * MiB + 512 * 1024;
constexpr size_t WS_W = 8 * MiB;
constexpr size_t W_IN = 0, W_FF1 = 6815744, W_FF2 = W_FF1 + 8 * MiB, W_OUT = W_FF2 + 8 * MiB, W_PA = W_OUT + 2 * MiB, W_PB = W_PA + 1 * MiB,
                 W_UQ = W_PB + 1 * MiB, W_UKV = W_UQ + 589824, W_POOL = W_UKV + 524288, W_END = W_POOL + 524288;
static_assert(W_END <= 29 * MiB, "weights");
constexpr size_t WS_GA = 37 * MiB, WS_GB = 69 * MiB, WS_AB = 101 * MiB, WS_ZA = 133 * MiB, WS_P = 170 * MiB, WS_Q = 186 * MiB, WS_K = 210 * MiB, WS_VT = 234 * MiB;
constexpr size_t WS_H = 186 * MiB;
constexpr size_t WS_TMP = 133 * MiB;
constexpr size_t WS_MRG = 197 * MiB;
constexpr size_t WS_F = 37 * MiB;
static_assert(WS_F + 128 * MiB <= WS_MRG, "F vs h2");
constexpr size_t WS_H2 = 165 * MiB;
constexpr size_t WS_CNT = 16384;
constexpr size_t WS_SLOTS = 7 * MiB;
constexpr size_t CTL_ZERO_BYTES = 16384 + 4 * 64 * 256;
constexpr int LDS_BYTES = 148480;

struct Params {
    const float* x; const float* c; const int* pos;
    const float *ln1_g, *ln2_g, *w_ada, *b_ada, *w_in, *q_norm_g, *w_uq, *kv_norm_g, *w_uk, *w_uv, *w_pool, *pool_scale, *p_pool, *p_attn, *w_out, *w_ff1, *w_ff2, *final_g;
    float* out; unsigned char* ws;
    int ph_lo, ph_hi, widx, pad;
};

__device__ __forceinline__ unsigned f2bf(float f) { unsigned u = __builtin_bit_cast(unsigned, f); return (u + 0x7fffu + ((u >> 16) & 1u)) >> 16; }
typedef __bf16 bf16x2_t __attribute__((ext_vector_type(2)));
typedef float f32x2_t __attribute__((ext_vector_type(2)));
__device__ __forceinline__ unsigned pk2(float lo, float hi) { const f32x2_t v = {lo, hi}; const bf16x2_t b = __builtin_convertvector(v, bf16x2_t); return __builtin_bit_cast(unsigned, b); }
__device__ __forceinline__ float bf2f(bf16_t v) { return __builtin_bit_cast(float, (unsigned)v << 16); }
__device__ __forceinline__ float bflo(unsigned w) { return __builtin_bit_cast(float, w << 16); }
__device__ __forceinline__ float bfhi(unsigned w) { return __builtin_bit_cast(float, w & 0xffff0000u); }
__device__ __forceinline__ float wave_sum(float v) {
#pragma unroll
    for (int o = 1; o < 64; o <<= 1) v += __shfl_xor(v, o);
    return v;
}
__device__ __forceinline__ float sigmoidf(float v) { return 1.0f / (1.0f + __expf(-v)); }
__device__ __forceinline__ int opaque_tid(int widx) { int l = __builtin_amdgcn_mbcnt_hi(~0u, __builtin_amdgcn_mbcnt_lo(~0u, 0u)); asm volatile("" : "+v"(l)); return widx * 64 + l; }
#define LDS_WAIT() asm volatile("s_waitcnt lgkmcnt(0)" ::: "memory")

constexpr int BM = 256, BK = 64, HALF = 128, HTB = HALF * BK * 2;
__device__ __forceinline__ int lds_byte(int r, int c) { int st = (r >> 4) * 2 + (c >> 5), rr = r & 15, cc = c & 31, ob = rr * 64 + cc * 2; return st * 1024 + (ob ^ (((ob >> 9) & 1) << 5)); }
__device__ __forceinline__ void stage_rc(int b, int& R, int& C) { int st = b / 1024, sb = b % 1024, swz = sb ^ (((sb >> 9) & 1) << 5); R = (st >> 1) * 16 + swz / 64; C = (st & 1) * 32 + (swz % 64) / 2; }

typedef f32x4 acc_t[2][2][4][2];

#if !NAIVE_GEMM
template <class Epi, bool DUAL = false, long A2OFF = 0, long B2OFF = 0, bool PERM = false>
__device__ __forceinline__ void gemm_tile(unsigned char* shm, const bf16_t* __restrict__ A, int lda, const bf16_t* __restrict__ Bt, int ldb, int K, int brow, int bcol, const Epi& epi, int widx) {
#define SA(b, h) (shm + ((b) * 2 + (h)) * HTB)
#define SB(b, h) (shm + (4 + (b) * 2 + (h)) * HTB)
#define STAGE_A(P, br, kt) do { const bf16_t* _g = (A + (size_t)(kt) * BK + ((DUAL && (kt) >= 8) ? (A2OFF - 8 * BK) : 0)) + (size_t)(br) * lda; \
    _Pragma("unroll") for (int _i = 0; _i < 2; ++_i) __builtin_amdgcn_global_load_lds((const unsigned*)(_g + offA[_i]), (unsigned*)((P) + wid * 1024 + _i * 8192), 16, 0, 0); } while (0)
#define STAGE_B(P, br, kt) do { const bf16_t* _g = (Bt + (size_t)(kt) * BK + ((DUAL && (kt) >= 8) ? (B2OFF - 8 * BK) : 0)) + (size_t)(br) * ldb; \
    _Pragma("unroll") for (int _i = 0; _i < 2; ++_i) __builtin_amdgcn_global_load_lds((const unsigned*)(_g + offB[_i]), (unsigned*)((P) + wid * 1024 + _i * 8192), 16, 0, 0); } while (0)
#define LDA(dst, b, h) _Pragma("unroll") for (int m = 0; m < 4; ++m) _Pragma("unroll") for (int k = 0; k < 2; ++k) \
    dst[m][k] = *reinterpret_cast<const bf16x8*>(SA(b, h) + aoff + m * 2048 + k * 1024)
#define LDB(dst, b, h) _Pragma("unroll") for (int n = 0; n < 2; ++n) _Pragma("unroll") for (int k = 0; k < 2; ++k) \
    dst[n][k] = *reinterpret_cast<const bf16x8*>(SB(b, h) + boff + n * 2048 + k * 1024)
#define MMA(ai, bj, At_, Bt_) do { __builtin_amdgcn_s_setprio(1); \
    _Pragma("unroll") for (int m = 0; m < 4; ++m) _Pragma("unroll") for (int n = 0; n < 2; ++n) _Pragma("unroll") for (int k = 0; k < 2; ++k) \
      acc[ai][bj][m][n] = __builtin_amdgcn_mfma_f32_16x16x32_bf16(Bt_[n][k], At_[m][k], acc[ai][bj][m][n], 0, 0, 0); \
    __builtin_amdgcn_s_setprio(0); } while (0)
#define WAIT_V(n) asm volatile("s_waitcnt vmcnt(" #n ")" ::: "memory")
#define WAIT_L(n) asm volatile("s_waitcnt lgkmcnt(" #n ")" ::: "memory")
#define BAR __builtin_amdgcn_s_barrier()
#define SCHED __builtin_amdgcn_sched_barrier(0)
    const int tid = opaque_tid(widx), wid = widx, lane = tid & 63, wr = wid >> 2, wc = wid & 3, fr = lane & 15, fq = lane >> 4;
    int offA[2], offB[2];
#pragma unroll
    for (int i = 0; i < 2; ++i) { int R, C; stage_rc(tid * 16 + i * 8192, R, C); const int rho = R & 31, Rb = PERM ? ((R & ~31) + 8 * ((rho & 15) >> 2) + 4 * (rho >> 4) + (rho & 3)) : R; offA[i] = R * lda + C; offB[i] = Rb * ldb + C; }
    const int aoff = lds_byte(wr * 64 + fr, fq * 8), boff = lds_byte(wc * 32 + fr, fq * 8);
    acc_t acc;
#pragma unroll
    for (int a = 0; a < 2; ++a)
#pragma unroll
        for (int b = 0; b < 2; ++b)
#pragma unroll
            for (int m = 0; m < 4; ++m)
#pragma unroll
                for (int n = 0; n < 2; ++n) acc[a][b][m][n] = (f32x4){0.f, 0.f, 0.f, 0.f};
    bf16x8 At[4][2], B0[2][2], B1[2][2];
    const int nt = K / BK;
    STAGE_B(SB(0, 0), bcol, 0); STAGE_A(SA(0, 0), brow, 0);
    STAGE_B(SB(0, 1), bcol + HALF, 0); STAGE_A(SA(0, 1), brow + HALF, 0);
    if (wr == 1) BAR;
    WAIT_V(4); BAR;
    STAGE_B(SB(1, 0), bcol, 1); STAGE_A(SA(1, 0), brow, 1); STAGE_B(SB(1, 1), bcol + HALF, 1);
    WAIT_V(6); BAR;
    for (int t = 0; t < nt - 2; t += 2) {
        if constexpr (DUAL) { if (t == 8) epi.mid(acc, brow, bcol, wr, wc, fr, fq); }
        LDB(B0, 0, 0); SCHED; LDA(At, 0, 0); STAGE_A(SA(1, 1), brow + HALF, t + 1);
        WAIT_L(8); BAR; WAIT_L(0); MMA(0, 0, At, B0); BAR; SCHED;
        LDB(B1, 0, 1); STAGE_B(SB(0, 0), bcol, t + 2);
        BAR; WAIT_L(0); MMA(0, 1, At, B1); BAR;
        LDA(At, 0, 1); STAGE_A(SA(0, 0), brow, t + 2);
        BAR; WAIT_L(0); MMA(1, 0, At, B0); BAR; SCHED;
        STAGE_B(SB(0, 1), bcol + HALF, t + 2);
        WAIT_V(6); BAR; MMA(1, 1, At, B1); BAR;
        LDB(B0, 1, 0); SCHED; LDA(At, 1, 0); STAGE_A(SA(0, 1), brow + HALF, t + 2);
        WAIT_L(8); BAR; WAIT_L(0); MMA(0, 0, At, B0); BAR; SCHED;
        LDB(B1, 1, 1); STAGE_B(SB(1, 0), bcol, t + 3);
        BAR; WAIT_L(0); MMA(0, 1, At, B1); BAR;
        LDA(At, 1, 1); STAGE_A(SA(1, 0), brow, t + 3);
        BAR; WAIT_L(0); MMA(1, 0, At, B0); BAR; SCHED;
        STAGE_B(SB(1, 1), bcol + HALF, t + 3);
        WAIT_V(6); BAR; MMA(1, 1, At, B1); BAR;
    }
    { LDB(B0, 0, 0); LDA(At, 0, 0); STAGE_A(SA(1, 1), brow + HALF, nt - 1);
      BAR; WAIT_L(0); MMA(0, 0, At, B0); BAR;
      LDB(B1, 0, 1); BAR; WAIT_L(0); MMA(0, 1, At, B1); BAR;
      LDA(At, 0, 1); WAIT_V(4); BAR; WAIT_L(0); MMA(1, 0, At, B0); MMA(1, 1, At, B1); BAR; }
    { LDB(B0, 1, 0); LDA(At, 1, 0); WAIT_V(2); BAR; WAIT_L(0); MMA(0, 0, At, B0); BAR;
      LDB(B1, 1, 1); WAIT_V(0); BAR; WAIT_L(0); MMA(0, 1, At, B1); BAR;
      LDA(At, 1, 1); BAR; WAIT_L(0); MMA(1, 0, At, B0); MMA(1, 1, At, B1); BAR; }
    if (wr == 0) BAR;
    { const int lane2 = opaque_tid(widx) & 63;
      epi(acc, brow, bcol, wr, wc, lane2 & 15, lane2 >> 4); }
    __syncthreads();
#undef SA
#undef SB
#undef STAGE_A
#undef STAGE_B
#undef LDA
#undef LDB
#undef MMA
}
#else
template <class Epi>
__device__ __forceinline__ void gemm_tile(unsigned char* shm, const bf16_t* __restrict__ A, int lda, const bf16_t* __restrict__ Bt, int ldb, int K, int brow, int bcol, const Epi& epi, int widx) {
    const int tid = opaque_tid(widx), wid = widx, lane = tid & 63, wr = wid >> 2, wc = wid & 3, fr = lane & 15, fq = lane >> 4;
    acc_t acc;
#pragma unroll
    for (int a = 0; a < 2; ++a)
#pragma unroll
        for (int b = 0; b < 2; ++b)
#pragma unroll
            for (int m = 0; m < 4; ++m)
#pragma unroll
                for (int n = 0; n < 2; ++n) acc[a][b][m][n] = (f32x4){0.f, 0.f, 0.f, 0.f};
    for (int k = 0; k < K; ++k) {
        float av[2][4], bv[2][2][4];
#pragma unroll
        for (int ai = 0; ai < 2; ++ai)
#pragma unroll
            for (int m = 0; m < 4; ++m) av[ai][m] = bf2f(A[(size_t)(brow + ai * 128 + wr * 64 + m * 16 + fr) * lda + k]);
#pragma unroll
        for (int bj = 0; bj < 2; ++bj)
#pragma unroll
            for (int n = 0; n < 2; ++n)
#pragma unroll
                for (int j = 0; j < 4; ++j) bv[bj][n][j] = bf2f(Bt[(size_t)(bcol + bj * 128 + wc * 32 + n * 16 + fq * 4 + j) * ldb + k]);
#pragma unroll
        for (int ai = 0; ai < 2; ++ai)
#pragma unroll
            for (int bj = 0; bj < 2; ++bj)
#pragma unroll
                for (int m = 0; m < 4; ++m)
#pragma unroll
                    for (int n = 0; n < 2; ++n)
#pragma unroll
                        for (int j = 0; j < 4; ++j) acc[ai][bj][m][n][j] += av[ai][m] * bv[bj][n][j];
    }
    epi(acc, brow, bcol, wr, wc, fr, fq);
}
#endif

__device__ __forceinline__ bool tile_of(int L, int nM, int nN, int& pm, int& pn) {
    const int nwg = nM * nN; if (L >= nwg) return false;
    int wgid = L; { const int q = nwg / 8, r = nwg % 8, xcd = wgid % 8, off = wgid / 8; wgid = (xcd < r ? xcd * (q + 1) : r * (q + 1) + (xcd - r) * q) + off; }
    const int nig = 8 * nN, gid = wgid / nig, fm = gid * 8, gsz = (nM - fm) < 8 ? (nM - fm) : 8;
    pm = fm + ((wgid % nig) % gsz); pn = (wgid % nig) / gsz; return true;
}


#if !NAIVE_GEMM
template <class Epi, bool AFTER_DRAIN = false, bool DUAL = false, long A2OFF = 0, long B2OFF = 0, bool PERM = false>
__device__ __forceinline__ void gemm_stream(unsigned char* shm, const bf16_t* __restrict__ A, int lda, const bf16_t* __restrict__ Bt, int ldb, int K, int nN, const Epi& epi, int widx) {
    const int tid = opaque_tid(widx), wid = widx, lane = tid & 63, wr = wid >> 2, wc = wid & 3, fr = lane & 15, fq = lane >> 4;
    const int nt = K / BK, nM = T / 256;
    unsigned voffA[2], voffB[2];
#pragma unroll
    for (int i = 0; i < 2; ++i) { int R, C; stage_rc(tid * 16 + i * 8192, R, C);
        const int rho = R & 31, Rb = PERM ? ((R & ~31) + 8 * ((rho & 15) >> 2) + 4 * (rho >> 4) + (rho & 3)) : R;
        voffA[i] = (unsigned)(R * lda + C) * 2u; voffB[i] = (unsigned)(Rb * ldb + C) * 2u; }
    const size_t kstep = (size_t)(BK * 2), hstepA = (size_t)HALF * lda * 2, hstepB = (size_t)HALF * ldb * 2, tstepA = 2 * hstepA, tstepB = 2 * hstepB;
#define GS_SA(b, h) (((b) * 2 + (h)) * HTB)
#define GS_SB(b, h) ((4 + (b) * 2 + (h)) * HTB)
#define GS_STAGE(bufoff, gbase, voff) do { _Pragma("unroll") for (int _i = 0; _i < 2; ++_i) { unsigned _vo = (voff)[_i]; asm volatile("" : "+v"(_vo));   \
        __builtin_amdgcn_global_load_lds((const unsigned*)((const char*)(gbase) + _vo), (unsigned*)(shm + (bufoff) + wid * 1024 + _i * 8192), 16, 0, 0); } } while (0)
#define GS_LDA(dst, b, h) do { _Pragma("unroll") for (int m = 0; m < 4; ++m) _Pragma("unroll") for (int k = 0; k < 2; ++k) dst[m][k] = *reinterpret_cast<const bf16x8*>(shm + GS_SA(b, h) + aoff + m * 2048 + k * 1024); } while (0)
#define GS_LDB(dst, b, h) do { _Pragma("unroll") for (int n = 0; n < 2; ++n) _Pragma("unroll") for (int k = 0; k < 2; ++k) dst[n][k] = *reinterpret_cast<const bf16x8*>(shm + GS_SB(b, h) + boff + n * 2048 + k * 1024); } while (0)
#define GS_MMA(ai, bj, At_, Bt_) do { __builtin_amdgcn_s_setprio(1); _Pragma("unroll") for (int m = 0; m < 4; ++m) _Pragma("unroll") for (int n = 0; n < 2; ++n) _Pragma("unroll") for (int k = 0; k < 2; ++k) \
        acc[ai][bj][m][n] = __builtin_amdgcn_mfma_f32_16x16x32_bf16(Bt_[n][k], At_[m][k], acc[ai][bj][m][n], 0, 0, 0); __builtin_amdgcn_s_setprio(0); } while (0)
    int pm, pn; int bxo = blockIdx.x; asm volatile("" : "+s"(bxo));
    if (!tile_of(bxo, nM, nN, pm, pn)) return;
    acc_t acc;
#pragma unroll
    for (int a = 0; a < 2; ++a)
#pragma unroll
        for (int b = 0; b < 2; ++b)
#pragma unroll
            for (int m = 0; m < 4; ++m)
#pragma unroll
                for (int n = 0; n < 2; ++n) acc[a][b][m][n] = (f32x4){0.f, 0.f, 0.f, 0.f};
    bf16x8 At[4][2], B0[2][2], B1[2][2];
    const char* cA = (const char*)A + (size_t)pm * tstepA; const char* cB = (const char*)Bt + (size_t)pn * tstepB;
    GS_STAGE(GS_SB(0, 0), cB, voffB); GS_STAGE(GS_SB(0, 1), cB + hstepB, voffB); GS_STAGE(GS_SA(0, 0), cA, voffA); GS_STAGE(GS_SA(0, 1), cA + hstepA, voffA);
    if (wr == 1) BAR;
    WAIT_V(2); BAR;
    GS_STAGE(GS_SB(1, 0), cB + kstep, voffB); GS_STAGE(GS_SA(1, 0), cA + kstep, voffA); GS_STAGE(GS_SB(1, 1), cB + hstepB + kstep, voffB);
    WAIT_V(6); BAR;
    const int aoff = lds_byte(wr * 64 + fr, fq * 8), boff = lds_byte(wc * 32 + fr, fq * 8);
    for (int ui = 0;; ++ui) {
        int pm2 = 0, pn2 = 0; const bool has_next = AFTER_DRAIN ? false : tile_of((ui + 1) * gridDim.x + bxo, nM, nN, pm2, pn2);
        const char* nA = has_next ? (const char*)A + (size_t)pm2 * tstepA : cA; const char* nB = has_next ? (const char*)Bt + (size_t)pn2 * tstepB : cB;
        for (int t = 0; t < nt; t += 2) {
            const bool last = (t == nt - 2);
            if constexpr (DUAL) { if (t == 8) { const int lane2 = opaque_tid(widx) & 63; epi.mid(acc, pm * 256, pn * 256, wr, wc, lane2 & 15, lane2 >> 4); } }
            const long da = (DUAL && t + 1 >= 8) ? (A2OFF * 2 - 8 * (long)kstep) : 0, da2 = (DUAL && t + 2 >= 8) ? (A2OFF * 2 - 8 * (long)kstep) : 0, db2 = (DUAL && t + 2 >= 8) ? (B2OFF * 2 - 8 * (long)kstep) : 0;
            const char* a1 = cA + (size_t)(t + 1) * kstep + da;
            const char* a2 = last ? nA : cA + (size_t)(t + 2) * kstep + da2; const char* b2 = last ? nB : cB + (size_t)(t + 2) * kstep + db2;
            const char* a3 = a2 + kstep; const char* b3 = b2 + kstep;
            GS_LDB(B0, 0, 0); GS_LDB(B1, 0, 1); SCHED; GS_LDA(At, 0, 0); GS_STAGE(GS_SA(1, 1), a1 + hstepA, voffA);
            WAIT_V(8); WAIT_L(0); BAR; GS_MMA(0, 0, At, B0); GS_MMA(0, 1, At, B1); BAR; SCHED;
            GS_LDA(At, 0, 1); GS_STAGE(GS_SB(0, 0), b2, voffB); GS_STAGE(GS_SB(0, 1), b2 + hstepB, voffB); GS_STAGE(GS_SA(0, 0), a2, voffA);
            WAIT_V(8); WAIT_L(0); BAR; GS_MMA(1, 0, At, B0); GS_MMA(1, 1, At, B1); BAR; SCHED;
            GS_LDB(B0, 1, 0); GS_LDB(B1, 1, 1); SCHED; GS_LDA(At, 1, 0); GS_STAGE(GS_SA(0, 1), a2 + hstepA, voffA);
            WAIT_V(8); WAIT_L(0); BAR; GS_MMA(0, 0, At, B0); GS_MMA(0, 1, At, B1); BAR; SCHED;
            GS_LDA(At, 1, 1); GS_STAGE(GS_SB(1, 0), b3, voffB); GS_STAGE(GS_SB(1, 1), b3 + hstepB, voffB); GS_STAGE(GS_SA(1, 0), a3, voffA);
            WAIT_V(8); WAIT_L(0); BAR; GS_MMA(1, 0, At, B0); GS_MMA(1, 1, At, B1); BAR; SCHED;
        }
        if (wr == 0) BAR;
        if (!AFTER_DRAIN) { const int lane2 = opaque_tid(widx) & 63; epi(acc, pm * 256, pn * 256, wr, wc, lane2 & 15, lane2 >> 4); }
        if (!has_next) break;
#pragma unroll
        for (int a = 0; a < 2; ++a)
#pragma unroll
            for (int b = 0; b < 2; ++b)
#pragma unroll
                for (int m = 0; m < 4; ++m)
#pragma unroll
                    for (int n = 0; n < 2; ++n) acc[a][b][m][n] = (f32x4){0.f, 0.f, 0.f, 0.f};
        pm = pm2; pn = pn2; cA = nA; cB = nB;
        if (wr == 1) BAR;
    }
    WAIT_V(0);
    BAR;
    __syncthreads();
    if (AFTER_DRAIN) { const int lane2 = opaque_tid(widx) & 63; epi(acc, pm * 256, pn * 256, wr, wc, lane2 & 15, lane2 >> 4); __syncthreads(); }
#undef GS_SA
#undef GS_SB
#undef GS_STAGE
#undef GS_LDA
#undef GS_LDB
#undef GS_MMA
}
#else
template <class Epi>
__device__ __forceinline__ void gemm_stream(unsigned char* shm, const bf16_t* __restrict__ A, int lda, const bf16_t* __restrict__ Bt, int ldb, int K, int nN, const Epi& epi, int widx) {
    for (int i = 0;; ++i) { int pm, pn; if (!tile_of(i * gridDim.x + blockIdx.x, T / 256, nN, pm, pn)) break; gemm_tile(shm, A, lda, Bt, ldb, K, pm * 256, pn * 256, epi, widx); }
}
#endif

#define EPI_ROWS _Pragma("unroll") for (int ai = 0; ai < 2; ++ai) _Pragma("unroll") for (int m = 0; m < 4; ++m)
#define EPI_COLS _Pragma("unroll") for (int bj = 0; bj < 2; ++bj) _Pragma("unroll") for (int n = 0; n < 2; ++n)
#define EPI_ROW (brow + ai * 128 + wr * 64 + m * 16 + fr)
#define EPI_COL (bcol + bj * 128 + wc * 32 + n * 16 + fq * 4)

struct EpiInproj {
    bf16_t *ZA, *GA, *GB;
    __device__ __forceinline__ void operator()(const acc_t& acc, int brow, int bcol, int wr, int wc, int fr, int fq) const {
        EPI_ROWS { const size_t row = EPI_ROW;
            EPI_COLS { const int col = EPI_COL; const f32x4 v = acc[ai][bj][m][n]; u32x2 w; w.x = pk2(v[0], v[1]); w.y = pk2(v[2], v[3]);
                if (col < 1184) *(u32x2*)(ZA + row * ZA_LD + col) = w;
                else if (col < 2208) *(u32x2*)(GA + row * 1024 + (col - 1184)) = w;
                else if (col < 3232) *(u32x2*)(GB + row * 1024 + (col - 2208)) = w; } }
    }
};
struct EpiInprojP {
    bf16_t *ZA, *GA, *GB;
    __device__ __forceinline__ void operator()(const acc_t& acc, int brow, int bcol, int wr, int wc, int fr, int fq) const {
        EPI_ROWS { const size_t row = EPI_ROW;
#pragma unroll
            for (int bj = 0; bj < 2; ++bj) { const int col = bcol + bj * 128 + wc * 32 + 8 * fq; const f32x4 v0 = acc[ai][bj][m][0], v1 = acc[ai][bj][m][1];
                u32x4 w; w.x = pk2(v0[0], v0[1]); w.y = pk2(v0[2], v0[3]); w.z = pk2(v1[0], v1[1]); w.w = pk2(v1[2], v1[3]);
                if (col < 1184) *(u32x4*)(ZA + row * ZA_LD + col) = w;
                else if (col < 2208) *(u32x4*)(GA + row * 1024 + (col - 1184)) = w;
                else if (col < 3232) *(u32x4*)(GB + row * 1024 + (col - 2208)) = w; } }
    }
};
struct EpiFF1P {
    bf16_t* F;
    __device__ __forceinline__ void operator()(const acc_t& acc, int brow, int bcol, int wr, int wc, int fr, int fq) const {
        EPI_ROWS { const size_t row = EPI_ROW;
#pragma unroll
            for (int bj = 0; bj < 2; ++bj) { const int col = bcol + bj * 128 + wc * 32 + 8 * fq; f32x4 v0 = acc[ai][bj][m][0], v1 = acc[ai][bj][m][1];
#pragma unroll
                for (int j = 0; j < 4; ++j) { const float r0 = fmaxf(v0[j], 0.f), r1 = fmaxf(v1[j], 0.f); v0[j] = r0 * r0; v1[j] = r1 * r1; }
                u32x4 w; w.x = pk2(v0[0], v0[1]); w.y = pk2(v0[2], v0[3]); w.z = pk2(v1[0], v1[1]); w.w = pk2(v1[2], v1[3]);
                *(u32x4*)(F + row * DFF + col) = w; } }
    }
};
struct EpiPoolP {
    bf16_t* AB; const float* scale;
    __device__ __forceinline__ void operator()(const acc_t& acc, int brow, int bcol, int wr, int wc, int fr, int fq) const {
        f32x4 sc0[2], sc1[2];
#pragma unroll
        for (int bj = 0; bj < 2; ++bj) { const int col = bcol + bj * 128 + wc * 32 + 8 * fq; sc0[bj] = *(const f32x4*)(scale + col); sc1[bj] = *(const f32x4*)(scale + col + 4); }
        EPI_ROWS { const size_t row = EPI_ROW;
#pragma unroll
            for (int bj = 0; bj < 2; ++bj) { const int col = bcol + bj * 128 + wc * 32 + 8 * fq; const f32x4 v0 = acc[ai][bj][m][0] * sc0[bj], v1 = acc[ai][bj][m][1] * sc1[bj];
                u32x4 w; w.x = pk2(v0[0], v0[1]); w.y = pk2(v0[2], v0[3]); w.z = pk2(v1[0], v1[1]); w.w = pk2(v1[2], v1[3]); *(u32x4*)(AB + row * 1024 + col) = w; } }
    }
};
struct EpiKP {
    bf16_t* Kk; const float* rstd;
    __device__ __forceinline__ void operator()(const acc_t& acc, int brow, int bcol, int wr, int wc, int fr, int fq) const {
        EPI_ROWS { const size_t row = EPI_ROW; const float rs = rstd[row];
#pragma unroll
            for (int bj = 0; bj < 2; ++bj) { const int col = bcol + bj * 128 + wc * 32 + 8 * fq; const f32x4 v0 = acc[ai][bj][m][0] * rs, v1 = acc[ai][bj][m][1] * rs;
                u32x4 w; w.x = pk2(v0[0], v0[1]); w.y = pk2(v0[2], v0[3]); w.z = pk2(v1[0], v1[1]); w.w = pk2(v1[2], v1[3]);
                *(u32x4*)(Kk + row * 768 + (col >> 6) * 96 + (col & 63)) = w; } }
    }
};
struct EpiPool {
    bf16_t* AB; const float* scale;
    __device__ __forceinline__ void operator()(const acc_t& acc, int brow, int bcol, int wr, int wc, int fr, int fq) const {
        EPI_ROWS { const size_t row = EPI_ROW;
            EPI_COLS { const int col = EPI_COL; const f32x4 v = acc[ai][bj][m][n] * *(const f32x4*)(scale + col); u32x2 w; w.x = pk2(v[0], v[1]); w.y = pk2(v[2], v[3]);
                *(u32x2*)(AB + row * 1024 + col) = w; } }
    }
};
struct EpiQ {
    bf16_t* Q; const float *rstd, *cs, *sn;
    __device__ __forceinline__ void operator()(const acc_t& acc, int brow, int bcol, int wr, int wc, int fr, int fq) const {
        EPI_ROWS { const size_t row = EPI_ROW; const float rs = rstd[row] * QSCALE;
            const f32x4 c4 = *(const f32x4*)(cs + row * 16 + fq * 4), s4 = *(const f32x4*)(sn + row * 16 + fq * 4);
#pragma unroll
            for (int bj = 0; bj < 2; ++bj) { const int col0 = bcol + bj * 128 + wc * 32; f32x4 v0 = acc[ai][bj][m][0] * rs, v1 = acc[ai][bj][m][1] * rs;
                if (((col0 >> 5) % 3) == 2) { const f32x4 r0 = v0 * c4 - v1 * s4, r1 = v1 * c4 + v0 * s4; v0 = r0; v1 = r1; }
                u32x2 w; w.x = pk2(v0[0], v0[1]); w.y = pk2(v0[2], v0[3]); *(u32x2*)(Q + row * 768 + col0 + fq * 4) = w;
                w.x = pk2(v1[0], v1[1]); w.y = pk2(v1[2], v1[3]); *(u32x2*)(Q + row * 768 + col0 + 16 + fq * 4) = w; } }
    }
};
struct EpiKV {
    bf16_t *Kk, *Vt; const float* rstd;
    __device__ __forceinline__ void operator()(const acc_t& acc, int brow, int bcol, int wr, int wc, int fr, int fq) const {
        EPI_ROWS { const size_t row = EPI_ROW; const float rs = rstd[row];
            EPI_COLS { const int col = EPI_COL; const f32x4 v = acc[ai][bj][m][n] * rs;
                if (col < 512) { u32x2 w; w.x = pk2(v[0], v[1]); w.y = pk2(v[2], v[3]); *(u32x2*)(Kk + row * 768 + (col >> 6) * 96 + (col & 63)) = w; }
                else { const size_t bb = row >> 12, s0_ = row & 4095, s = (s0_ & ~(size_t)12) | ((s0_ & 4) << 1) | ((s0_ & 8) >> 1); bf16_t* vp = Vt + (bb * 512 + (col - 512)) * 4096 + s;
                    vp[0] = (bf16_t)f2bf(v[0]); vp[4096] = (bf16_t)f2bf(v[1]); vp[8192] = (bf16_t)f2bf(v[2]); vp[12288] = (bf16_t)f2bf(v[3]); } } }
    }
};
struct EpiMerge1 {
    float* TMP; const bf16_t* GA;
    __device__ __forceinline__ void operator()(const acc_t& acc, int brow, int bcol, int wr, int wc, int fr, int fq) const {
        EPI_ROWS { const size_t row = EPI_ROW;
            EPI_COLS { const int col = EPI_COL; const u32x2 g = *(const u32x2*)(GA + row * 1024 + col); const f32x4 v = acc[ai][bj][m][n];
                f32x4 o; o[0] = sigmoidf(bflo(g.x)) * v[0]; o[1] = sigmoidf(bfhi(g.x)) * v[1]; o[2] = sigmoidf(bflo(g.y)) * v[2]; o[3] = sigmoidf(bfhi(g.y)) * v[3];
                *(f32x4*)(TMP + row * 1024 + col) = o; } }
    }
};
struct EpiMerge2 {
    const float* TMP; const bf16_t* GB; bf16_t* MRG;
    __device__ __forceinline__ void operator()(const acc_t& acc, int brow, int bcol, int wr, int wc, int fr, int fq) const {
        EPI_ROWS { const size_t row = EPI_ROW;
            EPI_COLS { const int col = EPI_COL; const u32x2 g = *(const u32x2*)(GB + row * 1024 + col); const f32x4 v = acc[ai][bj][m][n]; const f32x4 t = *(const f32x4*)(TMP + row * 1024 + col);
                f32x4 o; o[0] = t[0] + sigmoidf(bflo(g.x)) * v[0]; o[1] = t[1] + sigmoidf(bfhi(g.x)) * v[1]; o[2] = t[2] + sigmoidf(bflo(g.y)) * v[2]; o[3] = t[3] + sigmoidf(bfhi(g.y)) * v[3];
                u32x2 w; w.x = pk2(o[0], o[1]); w.y = pk2(o[2], o[3]); *(u32x2*)(MRG + row * 1024 + col) = w; } }
    }
};
struct EpiMergeDual {
    const bf16_t *GA, *GB; bf16_t* MRG;
    static __device__ __forceinline__ float em(float g) { return __builtin_amdgcn_exp2f(__builtin_amdgcn_fmed3f(g, -30.f, 30.f) * -1.4426950408889634f); }
    __device__ __forceinline__ void mid(acc_t& acc, int brow, int bcol, int wr, int wc, int fr, int fq) const {
        asm volatile("" : "+v"(fr), "+v"(fq));
        EPI_ROWS { const size_t row = EPI_ROW;
            EPI_COLS { const int col = EPI_COL; const u32x2 ga = *(const u32x2*)(GA + row * 1024 + col), gb = *(const u32x2*)(GB + row * 1024 + col);
                f32x4 r; r[0] = (1.f + em(bflo(gb.x))) * __builtin_amdgcn_rcpf(1.f + em(bflo(ga.x))); r[1] = (1.f + em(bfhi(gb.x))) * __builtin_amdgcn_rcpf(1.f + em(bfhi(ga.x)));
                r[2] = (1.f + em(bflo(gb.y))) * __builtin_amdgcn_rcpf(1.f + em(bflo(ga.y))); r[3] = (1.f + em(bfhi(gb.y))) * __builtin_amdgcn_rcpf(1.f + em(bfhi(ga.y)));
                acc[ai][bj][m][n] *= r; }
            asm volatile("" ::: "memory"); }
    }
    __device__ __forceinline__ void operator()(const acc_t& acc, int brow, int bcol, int wr, int wc, int fr, int fq) const {
        EPI_ROWS { const size_t row = EPI_ROW;
            EPI_COLS { const int col = EPI_COL; const u32x2 gb = *(const u32x2*)(GB + row * 1024 + col); const f32x4 v = acc[ai][bj][m][n];
                f32x4 o; o[0] = v[0] * __builtin_amdgcn_rcpf(1.f + em(bflo(gb.x))); o[1] = v[1] * __builtin_amdgcn_rcpf(1.f + em(bfhi(gb.x)));
                o[2] = v[2] * __builtin_amdgcn_rcpf(1.f + em(bflo(gb.y))); o[3] = v[3] * __builtin_amdgcn_rcpf(1.f + em(bfhi(gb.y)));
                u32x2 w; w.x = pk2(o[0], o[1]); w.y = pk2(o[2], o[3]); *(u32x2*)(MRG + row * 1024 + col) = w; } }
    }
};
struct EpiMergeDualP {
    const bf16_t *GA, *GB; bf16_t* MRG;
    static __device__ __forceinline__ float em(float g) { return __builtin_amdgcn_exp2f(__builtin_amdgcn_fmed3f(g, -30.f, 30.f) * -1.4426950408889634f); }
    static __device__ __forceinline__ float ratio(float gb, float ga) { return (1.f + em(gb)) * __builtin_amdgcn_rcpf(1.f + em(ga)); }
    __device__ __forceinline__ void mid(acc_t& acc, int brow, int bcol, int wr, int wc, int fr, int fq) const {
        asm volatile("" : "+v"(fr), "+v"(fq));
#pragma unroll
        for (int ai = 0; ai < 2; ++ai) {
            u32x4 ga[4][2], gb[4][2];
#pragma unroll
            for (int m = 0; m < 4; ++m) { const size_t row = EPI_ROW;
#pragma unroll
                for (int bj = 0; bj < 2; ++bj) { const int col = bcol + bj * 128 + wc * 32 + 8 * fq; ga[m][bj] = __builtin_nontemporal_load((const u32x4*)(GA + row * 1024 + col)); gb[m][bj] = *(const u32x4*)(GB + row * 1024 + col); } }
#pragma unroll
            for (int m = 0; m < 4; ++m)
#pragma unroll
                for (int bj = 0; bj < 2; ++bj) { const u32x4 a = ga[m][bj], b = gb[m][bj];
                    f32x4 r0, r1; r0[0] = ratio(bflo(b.x), bflo(a.x)); r0[1] = ratio(bfhi(b.x), bfhi(a.x)); r0[2] = ratio(bflo(b.y), bflo(a.y)); r0[3] = ratio(bfhi(b.y), bfhi(a.y));
                    r1[0] = ratio(bflo(b.z), bflo(a.z)); r1[1] = ratio(bfhi(b.z), bfhi(a.z)); r1[2] = ratio(bflo(b.w), bflo(a.w)); r1[3] = ratio(bfhi(b.w), bfhi(a.w));
                    acc[ai][bj][m][0] *= r0; acc[ai][bj][m][1] *= r1; }
            asm volatile("" ::: "memory");
        }
    }
    static __device__ __forceinline__ float sg(float g) { return __builtin_amdgcn_rcpf(1.f + em(g)); }
    __device__ __forceinline__ void operator()(const acc_t& acc, int brow, int bcol, int wr, int wc, int fr, int fq) const {
        EPI_ROWS { const size_t row = EPI_ROW;
#pragma unroll
            for (int bj = 0; bj < 2; ++bj) { const int col = bcol + bj * 128 + wc * 32 + 8 * fq; const u32x4 b = __builtin_nontemporal_load((const u32x4*)(GB + row * 1024 + col)); const f32x4 v0 = acc[ai][bj][m][0], v1 = acc[ai][bj][m][1];
                u32x4 w; w.x = pk2(v0[0] * sg(bflo(b.x)), v0[1] * sg(bfhi(b.x))); w.y = pk2(v0[2] * sg(bflo(b.y)), v0[3] * sg(bfhi(b.y)));
                w.z = pk2(v1[0] * sg(bflo(b.z)), v1[1] * sg(bfhi(b.z))); w.w = pk2(v1[2] * sg(bflo(b.w)), v1[3] * sg(bfhi(b.w)));
                *(u32x4*)(MRG + row * 1024 + col) = w; } }
    }
};
struct EpiRes {
    const float* xin; float* xout; const float* gate;
    __device__ __forceinline__ void operator()(const acc_t& acc, int brow, int bcol, int wr, int wc, int fr, int fq) const {
        const float* gb = gate + (size_t)(brow >> 12) * NMOD;
        EPI_ROWS { const size_t row = EPI_ROW;
            EPI_COLS { const int col = EPI_COL; const f32x4 g = *(const f32x4*)(gb + col); const f32x4 xi = __builtin_nontemporal_load((const f32x4*)(xin + row * 1024 + col));
                *(f32x4*)(xout + row * 1024 + col) = xi + g * acc[ai][bj][m][n]; } }
    }
};
template <int MODE, bool PL = false> struct EpiResNorm {
    const float* xin; float* xout; const float* gate; const float* ng; const float* nshift; const float* nscale; bf16_t* H; float* slots; unsigned* cnt; unsigned char* lds; int widx;
    __device__ __forceinline__ void operator()(acc_t& acc, int brow, int bcol, int wr, int wc, int fr, int fq) const {
        const int b = brow >> 12, pm = brow >> 8, pn = bcol >> 8;
        const float* gb = gate + (size_t)b * NMOD;
        float* P = (float*)lds; float* S = (float*)(lds + 4096);
        const int lane = fq * 16 + fr;
        EPI_ROWS { const size_t row = EPI_ROW; float sq = 0.f;
            EPI_COLS { const int col = PL ? (bcol + bj * 128 + wc * 32 + fq * 8 + n * 4) : EPI_COL; const f32x4 g = *(const f32x4*)(gb + col); const f32x4 xi = *(const f32x4*)(xin + row * 1024 + col);
                const f32x4 v = xi + g * acc[ai][bj][m][n]; acc[ai][bj][m][n] = v; sq += (v[0] * v[0] + v[1] * v[1]) + (v[2] * v[2] + v[3] * v[3]); }
            sq += __shfl_xor(sq, 16); sq += __shfl_xor(sq, 32);
            if (fq == 0) P[(ai * 128 + wr * 64 + m * 16 + fr) * 4 + wc] = sq; }
        __syncthreads();
        if (widx < 4) {
            const int r = widx * 64 + lane; const f32x4 pp = *(const f32x4*)(P + r * 4);
            __hip_atomic_store(slots + ((size_t)(brow + r) * 4 + pn), (pp[0] + pp[1]) + (pp[2] + pp[3]), __ATOMIC_RELAXED, __HIP_MEMORY_SCOPE_AGENT);
            asm volatile("s_waitcnt vmcnt(0)" ::: "memory");
            if (lane == 0) __hip_atomic_fetch_add(cnt + 64 * pm, 1u, __ATOMIC_RELAXED, __HIP_MEMORY_SCOPE_AGENT);
        }
        if (widx == 0) {
            unsigned sp = 0;
            while ((unsigned)__builtin_amdgcn_readfirstlane((int)__hip_atomic_load(cnt + 64 * pm, __ATOMIC_RELAXED, __HIP_MEMORY_SCOPE_AGENT)) < 16u) { __builtin_amdgcn_s_sleep(2); if (++sp > (1u << 22)) break; }
            __builtin_amdgcn_fence(__ATOMIC_ACQUIRE, "agent");
        }
        asm volatile("s_waitcnt vmcnt(0) lgkmcnt(0)" ::: "memory");
        __syncthreads();
        if (widx < 4) {
            const int r = widx * 64 + lane; const float* sl = slots + (size_t)(brow + r) * 4; float t = 0.f;
#pragma unroll
            for (int q = 0; q < 4; ++q) t += __hip_atomic_load(sl + q, __ATOMIC_RELAXED, __HIP_MEMORY_SCOPE_AGENT);
            S[r] = rsqrtf(t * (1.0f / 1024.0f) + EPS);
        }
        __syncthreads();
        f32x4 gsv[2][2], shv[2][2];
#pragma unroll
        for (int bj = 0; bj < 2; ++bj)
#pragma unroll
            for (int n = 0; n < 2; ++n) { const int col = PL ? (bcol + bj * 128 + wc * 32 + fq * 8 + n * 4) : EPI_COL; const f32x4 g4 = *(const f32x4*)(ng + col);
                if (MODE == 0) { gsv[bj][n] = g4 * (*(const f32x4*)(nscale + (size_t)b * NMOD + col) + 1.0f); shv[bj][n] = *(const f32x4*)(nshift + (size_t)b * NMOD + col); }
                else { gsv[bj][n] = g4; shv[bj][n] = g4; } }
        EPI_ROWS { const size_t row = EPI_ROW; const float rs = S[ai * 128 + wr * 64 + m * 16 + fr];
#pragma unroll
            for (int bj = 0; bj < 2; ++bj) { u32x2 wh[2];
#pragma unroll
                for (int n = 0; n < 2; ++n) { const int col = PL ? (bcol + bj * 128 + wc * 32 + fq * 8 + n * 4) : EPI_COL; const f32x4 v = acc[ai][bj][m][n]; const f32x4 g4 = gsv[bj][n];
                    if (MODE == 0) { *(f32x4*)(xout + row * 1024 + col) = v;
                        const f32x4 o = v * rs * g4 + shv[bj][n]; wh[n].x = pk2(o[0], o[1]); wh[n].y = pk2(o[2], o[3]);
                        if (!PL) *(u32x2*)(H + row * 1024 + col) = wh[n]; }
                    else __builtin_nontemporal_store(v * rs * g4, (f32x4*)(xout + row * 1024 + col)); }
                if (MODE == 0 && PL) *(u32x4*)(H + row * 1024 + bcol + bj * 128 + wc * 32 + fq * 8) = (u32x4){wh[0].x, wh[0].y, wh[1].x, wh[1].y}; } }
        __syncthreads();
    }
};
struct EpiFF1 {
    bf16_t* F;
    __device__ __forceinline__ void operator()(const acc_t& acc, int brow, int bcol, int wr, int wc, int fr, int fq) const {
        EPI_ROWS { const size_t row = EPI_ROW;
            EPI_COLS { const int col = EPI_COL; f32x4 v = acc[ai][bj][m][n];
#pragma unroll
                for (int j = 0; j < 4; ++j) { const float r = fmaxf(v[j], 0.f); v[j] = r * r; }
                u32x2 w; w.x = pk2(v[0], v[1]); w.y = pk2(v[2], v[3]); *(u32x2*)(F + row * DFF + col) = w; } }
    }
};

__device__ __forceinline__ void transpose_item(const float* __restrict__ W, int ldw, bf16_t* __restrict__ WT, int ldt, int k0, int n0, int drow0, int dcol0, const float* kscale, float* scr, int lane) {
    {
        const int kb = lane >> 3, n4 = (lane & 7) * 4; f32x4 v[8];
#pragma unroll
        for (int i = 0; i < 8; ++i) v[i] = __builtin_nontemporal_load((const f32x4*)(W + (size_t)(k0 + kb + 8 * i) * ldw + n0 + n4));
#pragma unroll
        for (int i = 0; i < 8; ++i) { const int kk = kb + 8 * i; f32x4 t = v[i]; if (kscale) t = t * kscale[k0 + kk];
            float* d = scr + kk * 33 + n4; d[0] = t[0]; d[1] = t[1]; d[2] = t[2]; d[3] = t[3]; }
    }
    LDS_WAIT(); asm volatile("" ::: "memory");
    const int c = lane & 7;
#pragma unroll
    for (int j = 0; j < 4; ++j) { const int n = (lane >> 3) + 8 * j; const float* s = scr + (8 * c) * 33 + n;
        u32x4 o; o.x = pk2(s[0 * 33], s[1 * 33]); o.y = pk2(s[2 * 33], s[3 * 33]); o.z = pk2(s[4 * 33], s[5 * 33]); o.w = pk2(s[6 * 33], s[7 * 33]);
        *(u32x4*)(WT + (size_t)(drow0 + n0 + n) * ldt + dcol0 + k0 + 8 * c) = o; }
    LDS_WAIT(); asm volatile("" ::: "memory");
}

__device__ __forceinline__ void convert_weights(const Params& p, int l, unsigned char* shm) {
    const int widx = p.widx;
    const int tid = opaque_tid(widx), wave = widx, lane = tid & 63;
    float* scr = (float*)(shm + wave * 16384);
    unsigned char* wb = p.ws + WS_W;
    const int gw = blockIdx.x * 8 + wave, NGW = gridDim.x * 8;
    constexpr int I_IN = 16 * 101, I_UQ = 6 * 24, I_UK = 4 * 16, I_UV = 4 * 16, I_POOL = 32, I_PA = 8 * 32, I_PB = 8 * 32, I_OUT = 16 * 32, I_FF1 = 16 * 128, I_FF2 = 64 * 32;
    constexpr int NITEMS = I_IN + I_UQ + I_UK + I_UV + I_POOL + I_PA + I_PB + I_OUT + I_FF1 + I_FF2;
    for (int it = gw; it < NITEMS; it += NGW) {
        int r = it;
        if (r < I_FF1) { transpose_item(p.w_ff1 + (size_t)l * 1024 * 4096, 4096, (bf16_t*)(wb + W_FF1), 1024, (r / 128) * 64, (r % 128) * 32, 0, 0, nullptr, scr, lane); continue; } r -= I_FF1;
        if (r < I_FF2) { transpose_item(p.w_ff2 + (size_t)l * 4096 * 1024, 1024, (bf16_t*)(wb + W_FF2), 4096, (r / 32) * 64, (r % 32) * 32, 0, 0, nullptr, scr, lane); continue; } r -= I_FF2;
        if (r < I_IN) { transpose_item(p.w_in + (size_t)l * 1024 * 3232, 3232, (bf16_t*)(wb + W_IN), 1024, (r / 101) * 64, (r % 101) * 32, 0, 0, nullptr, scr, lane); continue; } r -= I_IN;
        if (r < I_OUT) { transpose_item(p.w_out + (size_t)l * 1024 * 1024, 1024, (bf16_t*)(wb + W_OUT), 1024, (r / 32) * 64, (r % 32) * 32, 0, 0, nullptr, scr, lane); continue; } r -= I_OUT;
        if (r < I_PA) { transpose_item(p.p_pool + (size_t)l * 512 * 1024, 1024, (bf16_t*)(wb + W_PA), 512, (r / 32) * 64, (r % 32) * 32, 0, 0, nullptr, scr, lane); continue; } r -= I_PA;
        if (r < I_PB) { transpose_item(p.p_attn + (size_t)l * 512 * 1024, 1024, (bf16_t*)(wb + W_PB), 512, (r / 32) * 64, (r % 32) * 32, 0, 0, nullptr, scr, lane); continue; } r -= I_PB;
        if (r < I_UQ) { transpose_item(p.w_uq + (size_t)l * 384 * 768, 768, (bf16_t*)(wb + W_UQ), 384, (r / 24) * 64, (r % 24) * 32, 0, 0, p.q_norm_g + l * 384, scr, lane); continue; } r -= I_UQ;
        if (r < I_UK) { transpose_item(p.w_uk + (size_t)l * 256 * 512, 512, (bf16_t*)(wb + W_UKV), 256, (r / 16) * 64, (r % 16) * 32, 0, 0, p.kv_norm_g + l * 256, scr, lane); continue; } r -= I_UK;
        if (r < I_UV) { transpose_item(p.w_uv + (size_t)l * 256 * 512, 512, (bf16_t*)(wb + W_UKV), 256, (r / 16) * 64, (r % 16) * 32, 512, 0, p.kv_norm_g + l * 256, scr, lane); continue; } r -= I_UV;
        { const int g = r / 8, q = r % 8;
          transpose_item(p.w_pool + ((size_t)l * 4 + g) * 128 * 128, 128, (bf16_t*)(wb + W_POOL), 512, (q / 4) * 64, (q % 4) * 32, g * 128, g * 128, nullptr, scr, lane); }
    }
    const int gt = blockIdx.x * 512 + tid, NGT = gridDim.x * 512;
    unsigned zz = 0u; asm volatile("" : "+v"(zz)); const u32x4 z4 = {zz, zz, zz, zz};
    for (int i = gt; i < 96 * 1024 / 8; i += NGT) *(u32x4*)((bf16_t*)(wb + W_IN) + (size_t)3232 * 1024 + (size_t)i * 8) = z4;
    for (int i = gt; i < 512 * 512 / 8; i += NGT) { const int row = i / 64, col = (i % 64) * 8; if ((row >> 7) != (col >> 7)) *(u32x4*)((bf16_t*)(wb + W_POOL) + (size_t)row * 512 + col) = z4; }
}

__device__ __forceinline__ void phase_mod_partials(const Params& p, unsigned char* shm) {
    const int widx = p.widx;
    const int tid = opaque_tid(widx), wave = widx, lane = tid & 63;
    float* MODP = (float*)(p.ws + WS_MODP);
    float* cact = (float*)shm;
    __syncthreads();
#pragma unroll
    for (int q = 0; q < 8; ++q) { const float cv = p.c[tid + 512 * q]; cact[tid + 512 * q] = cv * sigmoidf(cv); }
    __syncthreads();
    const int NGW = gridDim.x * 8;
    for (int u = wave * gridDim.x + blockIdx.x; u < 2 * 96 * 8; u += NGW) {
        const int l = u / 768, r = u % 768, cgp = r / 8, kc = r % 8, col = cgp * 64 + lane;
        const float* w = p.w_ada + ((size_t)l * 1024 + kc * 128) * NMOD + col;
        float a0 = 0.f, a1 = 0.f, a2 = 0.f, a3 = 0.f;
#pragma unroll 1
        for (int k0 = 0; k0 < 128; k0 += 32) {
            float wv[32];
#pragma unroll
            for (int k = 0; k < 32; ++k) wv[k] = __builtin_nontemporal_load(w + (size_t)(k0 + k) * NMOD);
#pragma unroll
            for (int k = 0; k < 32; ++k) { const int kk = kc * 128 + k0 + k;
                a0 += cact[kk] * wv[k]; a1 += cact[1024 + kk] * wv[k]; a2 += cact[2048 + kk] * wv[k]; a3 += cact[3072 + kk] * wv[k]; }
        }
        float* o = MODP + ((size_t)(l * 8 + kc) * 4) * NMOD + col;
        o[0] = a0; o[NMOD] = a1; o[2 * NMOD] = a2; o[3 * NMOD] = a3;
    }
    float* COS = (float*)(p.ws + WS_COS); float* SIN = (float*)(p.ws + WS_SIN);
    const int gt = blockIdx.x * 512 + tid, NGT = gridDim.x * 512;
    for (int i = gt; i < T * 16; i += NGT) {
        const int t = i >> 4, k = i & 15;
        const float inv = powf(10000.0f, -(float)(2 * k) / 32.0f);
        const float ang = (float)p.pos[t] * inv;
        COS[i] = cosf(ang); SIN[i] = sinf(ang);
    }
}
__device__ __forceinline__ void phase_mod_final(const Params& p) {
    const int widx = p.widx;
    const float* MODP = (const float*)(p.ws + WS_MODP); float* MOD = (float*)(p.ws + WS_MOD);
    const int gt = blockIdx.x * 512 + opaque_tid(widx), NGT = gridDim.x * 512;
    for (int i = gt; i < 2 * 4 * NMOD; i += NGT) {
        const int l = i / (4 * NMOD), b = (i / NMOD) & 3, n = i % NMOD;
        float s = p.b_ada[l * NMOD + n];
#pragma unroll
        for (int kc = 0; kc < 8; ++kc) s += MODP[((size_t)(l * 8 + kc) * 4 + b) * NMOD + n];
        MOD[i] = s;
    }
}

__device__ __forceinline__ void phase_norm(const float* __restrict__ xin, const float* __restrict__ g, const float* __restrict__ shift, const float* __restrict__ scale  , bf16_t* __restrict__ H, int widx) {
    const int tid = opaque_tid(widx), wave = widx, lane = tid & 63;
    const int gw = blockIdx.x * 8 + wave, NGW = gridDim.x * 8;
    for (int r0 = gw * 8; r0 < T; r0 += NGW * 8) {
        const int b = r0 >> 12;
        f32x4 gs[4], sh[4];
#pragma unroll
        for (int j = 0; j < 4; ++j) { const int col = 4 * lane + 256 * j; gs[j] = *(const f32x4*)(g + col) * (*(const f32x4*)(scale + (size_t)b * NMOD + col) + 1.0f); sh[j] = *(const f32x4*)(shift + (size_t)b * NMOD + col); }
        for (int i = 0; i < 8; i += 4) {
            const size_t row = r0 + i; f32x4 v[4][4]; float s[4];
#pragma unroll
            for (int q = 0; q < 4; ++q)
#pragma unroll
                for (int j = 0; j < 4; ++j) v[q][j] = __builtin_nontemporal_load((const f32x4*)(xin + (row + q) * 1024 + 4 * lane + 256 * j));
#pragma unroll
            for (int q = 0; q < 4; ++q) { s[q] = 0.f;
#pragma unroll
                for (int j = 0; j < 4; ++j) s[q] += (v[q][j][0] * v[q][j][0] + v[q][j][1] * v[q][j][1]) + (v[q][j][2] * v[q][j][2] + v[q][j][3] * v[q][j][3]); }
#pragma unroll
            for (int q = 0; q < 4; ++q) { const float rstd = rsqrtf(wave_sum(s[q]) * (1.0f / 1024.0f) + EPS);
#pragma unroll
                for (int j = 0; j < 4; ++j) { const f32x4 o = v[q][j] * rstd * gs[j] + sh[j]; u32x2 w; w.x = pk2(o[0], o[1]); w.y = pk2(o[2], o[3]); *(u32x2*)(H + (row + q) * 1024 + 4 * lane + 256 * j) = w; } }
        }
    }
}
__device__ __forceinline__ void phase_final_norm(float* __restrict__ x, const float* __restrict__ g, int widx) {
    const int tid = opaque_tid(widx), wave = widx, lane = tid & 63;
    const int gw = blockIdx.x * 8 + wave, NGW = gridDim.x * 8;
    f32x4 gs[4];
#pragma unroll
    for (int j = 0; j < 4; ++j) gs[j] = *(const f32x4*)(g + 4 * lane + 256 * j);
    for (int row = gw; row < T; row += NGW) {
        f32x4 v[4]; float s = 0.f;
#pragma unroll
        for (int j = 0; j < 4; ++j) { v[j] = *(const f32x4*)(x + (size_t)row * 1024 + 4 * lane + 256 * j); s += (v[j][0] * v[j][0] + v[j][1] * v[j][1]) + (v[j][2] * v[j][2] + v[j][3] * v[j][3]); }
        const float rstd = rsqrtf(wave_sum(s) * (1.0f / 1024.0f) + EPS);
#pragma unroll
        for (int j = 0; j < 4; ++j) *(f32x4*)(x + (size_t)row * 1024 + 4 * lane + 256 * j) = v[j] * rstd * gs[j];
    }
}

__device__ __forceinline__ void phase_prep(const Params& p, unsigned char* shm) {
    const int widx = p.widx;
    const int tid = opaque_tid(widx), wave = widx, lane = tid & 63;
    const bf16_t* ZA = (const bf16_t*)(p.ws + WS_ZA); bf16_t* P = (bf16_t*)(p.ws + WS_P); bf16_t* Kk = (bf16_t*)(p.ws + WS_K);
    float* RSQ = (float*)(p.ws + WS_RSQ); float* RSKV = (float*)(p.ws + WS_RSKV);
    const float* COS = (const float*)(p.ws + WS_COS); const float* SIN = (const float*)(p.ws + WS_SIN);
    unsigned* tile = (unsigned*)shm;
    for (int t0 = blockIdx.x * 64; t0 < T; t0 += gridDim.x * 64) {
        const int s0 = t0 & 4095;
        __syncthreads();
#pragma unroll
        for (int r = 0; r < 10; ++r) { const int i = tid + 512 * r, row = i >> 6, c8 = (i & 63) * 8;
            u32x4 v = {0u, 0u, 0u, 0u};
            if (s0 - 16 + row >= 0) v = *(const u32x4*)(ZA + (size_t)(t0 - 16 + row) * ZA_LD + c8);
            *(u32x4*)(tile + row * 256 + (c8 >> 1)) = v; }
        {
            const int i8 = lane >> 3, sub = lane & 7; const size_t t = t0 + wave * 8 + i8; const bf16_t* z = ZA + t * ZA_LD;
            u32x4 qv[6], kv[4];
#pragma unroll
            for (int r = 0; r < 6; ++r) qv[r] = *(const u32x4*)(z + ZC_Q + (sub + 8 * r) * 8);
#pragma unroll
            for (int r = 0; r < 4; ++r) kv[r] = *(const u32x4*)(z + ZC_KV + (sub + 8 * r) * 8);
            float sq = 0.f, sk = 0.f;
#pragma unroll
            for (int r = 0; r < 6; ++r)
#pragma unroll
                for (int e = 0; e < 4; ++e) { const float a = bflo(qv[r][e]), b = bfhi(qv[r][e]); sq += a * a + b * b; }
#pragma unroll
            for (int r = 0; r < 4; ++r)
#pragma unroll
                for (int e = 0; e < 4; ++e) { const float a = bflo(kv[r][e]), b = bfhi(kv[r][e]); sk += a * a + b * b; }
            sq += __shfl_xor(sq, 1); sq += __shfl_xor(sq, 2); sq += __shfl_xor(sq, 4);
            sk += __shfl_xor(sk, 1); sk += __shfl_xor(sk, 2); sk += __shfl_xor(sk, 4);
            if (sub == 0) { RSQ[t] = rsqrtf(sq * (1.0f / 384.0f) + EPS); RSKV[t] = rsqrtf(sk * (1.0f / 256.0f) + EPS); }
            {
                const u32x4 xa0 = *(const u32x4*)(z + ZC_KR), xa1 = *(const u32x4*)(z + ZC_KR + 8), xb0 = *(const u32x4*)(z + ZC_KR + 16), xb1 = *(const u32x4*)(z + ZC_KR + 24);
                f32x4 c4[4], s4[4];
#pragma unroll
                for (int q = 0; q < 4; ++q) { c4[q] = *(const f32x4*)(COS + t * 16 + 4 * q); s4[q] = *(const f32x4*)(SIN + t * 16 + 4 * q); }
                u32x4 lo0, lo1, hi0, hi1;
#define ROPE2(XA, XB, e, k) { const float c0 = c4[(k) >> 2][(k) & 3], c1 = c4[((k) + 1) >> 2][((k) + 1) & 3], n0 = s4[(k) >> 2][(k) & 3], n1 = s4[((k) + 1) >> 2][((k) + 1) & 3]; const float a0 = bflo(XA[e]), a1 = bfhi(XA[e]), b0 = bflo(XB[e]), b1 = bfhi(XB[e]); \
                              lo = pk2(a0 * c0 - b0 * n0, a1 * c1 - b1 * n1); hi = pk2(b0 * c0 + a0 * n0, b1 * c1 + a1 * n1); }
#pragma unroll
                for (int e = 0; e < 4; ++e) { unsigned lo, hi; ROPE2(xa0, xb0, e, 2 * e) lo0[e] = lo; hi0[e] = hi; }
#pragma unroll
                for (int e = 0; e < 4; ++e) { unsigned lo, hi; ROPE2(xa1, xb1, e, 8 + 2 * e) lo1[e] = lo; hi1[e] = hi; }
#undef ROPE2
                bf16_t* kd = Kk + t * 768 + sub * 96 + 64;
                *(u32x4*)(kd) = lo0; *(u32x4*)(kd + 8) = lo1; *(u32x4*)(kd + 16) = hi0; *(u32x4*)(kd + 24) = hi1;
            }
        }
        __syncthreads();
        {
            const int co = tid & 63, i0 = (tid >> 6) * 8, w = 2 << (co >> 4);
            float sm[8];
#pragma unroll
            for (int e = 0; e < 8; ++e) sm[e] = 0.f;
            for (int j = 1; j <= w; ++j) { const u32x4 v = *(const u32x4*)(tile + (16 + i0 - j) * 256 + co * 4);
#pragma unroll
                for (int e = 0; e < 4; ++e) { sm[2 * e] += bflo(v[e]); sm[2 * e + 1] += bfhi(v[e]); } }
#pragma unroll
            for (int i = 0; i < 8; ++i) {
                const u32x4 v = *(const u32x4*)(tile + (16 + i0 + i) * 256 + co * 4), o = *(const u32x4*)(tile + (16 + i0 + i - w) * 256 + co * 4);
                const int sidx = s0 + i0 + i; const float rc = 1.0f / (float)(sidx + 1 < w ? sidx + 1 : w);
                u32x4 ow;
#pragma unroll
                for (int e = 0; e < 4; ++e) { const float vl = bflo(v[e]), vh = bfhi(v[e]); sm[2 * e] += vl - bflo(o[e]); sm[2 * e + 1] += vh - bfhi(o[e]);
                    ow[e] = pk2(sm[2 * e] * rc - vl, sm[2 * e + 1] * rc - vh); }
                *(u32x4*)(P + (size_t)(t0 + i0 + i) * 512 + 8 * co) = ow;
            }
        }
    }
}

#if !NAIVE_ATTN
#define ATT_SCHED do {} while (0)
#define ATT_MFMA(a, b, c) __builtin_amdgcn_mfma_f32_32x32x16_bf16(a, b, c, 0, 0, 0)
#define ATT_WAIT_V(n) asm volatile("s_waitcnt vmcnt(" #n ")" ::: "memory")
#define ATT_BAR do { __builtin_amdgcn_s_barrier(); asm volatile("" ::: "memory"); } while (0)
constexpr int ATT_STAGE = 24576, ATT_VOFF = 16384;
template <bool MASK>
__device__ __forceinline__ void attn_unit(const unsigned char* kb, const unsigned char* vb, int xr, int g2, const bf16x8 (&qf)[6], f32x16& sc, f32x16& sn, f32x16& o0, f32x16& o1,
                                          float& mrow, float& lsum, int kbase, int qrow, int hh) {
#define KFRAG(s) (*(const bf16x8*)(kb + ((((2 * (s)) + hh) ^ xr) << 4)))
#define VFRAG(dt, st) (*(const bf16x8*)(vb + (((((dt) * 8) + g2 + 2 * (st)) ^ xr) << 4)))
    const f32x16 zero16 = {0.f, 0.f, 0.f, 0.f, 0.f, 0.f, 0.f, 0.f, 0.f, 0.f, 0.f, 0.f, 0.f, 0.f, 0.f, 0.f};
    bf16x8 ka = KFRAG(0), kaN;
    kaN = KFRAG(1);
    sn = ATT_MFMA(ka, qf[0], zero16);
    ka = KFRAG(2);
    sn = ATT_MFMA(kaN, qf[1], sn);
    if (MASK) {
#pragma unroll
        for (int i = 0; i < 16; ++i) { const int key = kbase + (i & 3) + 8 * (i >> 2) + 4 * hh; if (key > qrow) sc[i] = -1e30f; }
    }
    float mx = fmaxf(sc[0], sc[1]);
#pragma unroll
    for (int i = 2; i < 16; ++i) mx = fmaxf(mx, sc[i]);
    ATT_SCHED;
    kaN = KFRAG(3);
    sn = ATT_MFMA(ka, qf[2], sn);
    ka = KFRAG(4);
    sn = ATT_MFMA(kaN, qf[3], sn);
    mx = fmaxf(mx, __shfl_xor(mx, 32));
    const bool grow = mx > mrow + 8.0f;
    if (__builtin_amdgcn_ballot_w64(grow) != 0ull) {
        const float mref = grow ? mx : mrow, alpha = __builtin_amdgcn_exp2f(mrow - mref); mrow = mref;
        lsum *= alpha;
#pragma unroll
        for (int i = 0; i < 16; ++i) { o0[i] *= alpha; o1[i] *= alpha; }
    }
    const float mnew = mrow;
    float ps = 0.f;
#pragma unroll
    for (int i = 0; i < 8; ++i) { sc[i] = __builtin_amdgcn_exp2f(sc[i] - mnew); ps += sc[i]; }
    u32x4 w0; w0.x = pk2(sc[0], sc[1]); w0.y = pk2(sc[2], sc[3]); w0.z = pk2(sc[4], sc[5]); w0.w = pk2(sc[6], sc[7]);
    ATT_SCHED;
    kaN = KFRAG(5);
    sn = ATT_MFMA(ka, qf[4], sn);
    const bf16x8 va = VFRAG(0, 0), vc = VFRAG(1, 0), vb2 = VFRAG(0, 1), vd = VFRAG(1, 1);
    sn = ATT_MFMA(kaN, qf[5], sn);
#pragma unroll
    for (int i = 8; i < 16; ++i) { sc[i] = __builtin_amdgcn_exp2f(sc[i] - mnew); ps += sc[i]; }
    u32x4 w1; w1.x = pk2(sc[8], sc[9]); w1.y = pk2(sc[10], sc[11]); w1.z = pk2(sc[12], sc[13]); w1.w = pk2(sc[14], sc[15]);
    lsum += ps;
    ATT_SCHED;
    const bf16x8 p0 = __builtin_bit_cast(bf16x8, w0), p1 = __builtin_bit_cast(bf16x8, w1);
    o0 = ATT_MFMA(va, p0, o0);
    o1 = ATT_MFMA(vc, p0, o1);
    o0 = ATT_MFMA(vb2, p1, o0);
    o1 = ATT_MFMA(vd, p1, o1);
#undef KFRAG
#undef VFRAG
}

__device__ __forceinline__ void phase_attn(const Params& p, unsigned char* shm) {
    const int widx = p.widx;
    const bf16_t* Q = (const bf16_t*)(p.ws + WS_Q); const bf16_t* Kg = (const bf16_t*)(p.ws + WS_K); const bf16_t* Vt = (const bf16_t*)(p.ws + WS_VT); bf16_t* AB = (bf16_t*)(p.ws + WS_AB);
    const int tid = opaque_tid(widx), wave = widx, lane = tid & 63, r = lane & 31, hh = lane >> 5, xr = r & 15;
    int kgo[2], vgo;
#pragma unroll
    for (int _i = 0; _i < 2; ++_i) { const int R = 8 * wave + 4 * _i + (lane >> 4), L = (lane & 15) ^ (R & 15); kgo[_i] = R * 768 + (L < 12 ? L : 0) * 8; }
    { const int R = 4 * wave + (lane >> 4), C = (lane & 15) ^ (R & 15), d = R + 32 * (C >> 3), c = C & 7; vgo = d * 4096 + c * 8; }
#define ATT_ISSUE(t) do { unsigned char* _st = shm + ((t) % 6) * ATT_STAGE; const bf16_t* _kg = kbase_g + (size_t)(t) * 64 * 768; const bf16_t* _vg = vbase_g + (size_t)(t) * 64; \
        __builtin_amdgcn_global_load_lds((const unsigned*)(_kg + kgo[0]), (unsigned*)(_st + wave * 2048), 16, 0, 0); \
        __builtin_amdgcn_global_load_lds((const unsigned*)(_kg + kgo[1]), (unsigned*)(_st + wave * 2048 + 1024), 16, 0, 0); \
        __builtin_amdgcn_global_load_lds((const unsigned*)(_vg + vgo), (unsigned*)(_st + ATT_VOFF + wave * 1024), 16, 0, 0); } while (0)
    for (int u = blockIdx.x; u < 256; u += gridDim.x) {
        int gdx = gridDim.x; asm volatile("" : "+s"(gdx));
        const int uu = (gdx == 256) ? ((u & 7) * 32 + (u >> 3)) : u;
        const int b = uu >> 6, h = (uu >> 3) & 7, x = uu & 7;
        const bf16_t* kbase_g = Kg + (size_t)(b * 4096) * 768 + h * 96;
        const bf16_t* vbase_g = Vt + (size_t)(b * 512 + h * 64) * 4096;
        for (int half = 0; half < 2; ++half) {
            const int qb = half == 0 ? 15 - x : x, q0 = qb * 256, nkt = (q0 + 256) / 64;
            const int qrow = q0 + wave * 32 + r, qmax = q0 + wave * 32 + 31;
            const bf16_t* qp = Q + (size_t)(b * 4096 + qrow) * 768 + h * 96 + hh * 8;
            bf16x8 qf[6];
#pragma unroll
            for (int s = 0; s < 6; ++s) qf[s] = *(const bf16x8*)(qp + 16 * s);
            ATT_WAIT_V(0); __syncthreads();
            ATT_ISSUE(0); ATT_ISSUE(1); ATT_ISSUE(2); ATT_ISSUE(3);
            f32x16 o0, o1, sc, sd;
#pragma unroll
            for (int i = 0; i < 16; ++i) { o0[i] = 0.f; o1[i] = 0.f; sc[i] = 0.f; sd[i] = 0.f; }
            float mrow = -1e30f, lsum = 0.f;
            ATT_WAIT_V(0); ATT_BAR;
            {
                const unsigned char* kb = shm + r * 256;
#pragma unroll
                for (int s = 0; s < 6; ++s) { const bf16x8 ka = *(const bf16x8*)(kb + (((2 * s + hh) ^ xr) << 4)); sc = ATT_MFMA(ka, qf[s], sc); }
            }
#define ATT_PAIR_HEAD() \
                const int ta = 2 * it, k0 = ta * 64; \
                if (ta + 3 < nkt) asm volatile("s_waitcnt vmcnt(3) lgkmcnt(0)" ::: "memory"); else asm volatile("s_waitcnt vmcnt(0) lgkmcnt(0)" ::: "memory"); \
                ATT_BAR; \
                if (ta + 4 < nkt) ATT_ISSUE(ta + 4); \
                if (ta + 5 < nkt) ATT_ISSUE(ta + 5); \
                const unsigned char* sta = shm + (ta % 6) * ATT_STAGE + r * 256; \
                const unsigned char* stb = shm + ((ta + 1) % 6) * ATT_STAGE + r * 256; \
                const unsigned char* stc2 = shm + ((ta + 2) % 6) * ATT_STAGE + r * 256;
            int it = 0;
            for (; it < nkt / 2 - 2; ++it) {
                ATT_PAIR_HEAD()
                attn_unit<false>(sta + 32 * 256, sta + ATT_VOFF, xr, hh, qf, sc, sd, o0, o1, mrow, lsum, k0, qrow, hh);
                attn_unit<false>(stb, sta + ATT_VOFF, xr, 4 + hh, qf, sd, sc, o0, o1, mrow, lsum, k0 + 32, qrow, hh);
                attn_unit<false>(stb + 32 * 256, stb + ATT_VOFF, xr, hh, qf, sc, sd, o0, o1, mrow, lsum, k0 + 64, qrow, hh);
                attn_unit<false>(stc2, stb + ATT_VOFF, xr, 4 + hh, qf, sd, sc, o0, o1, mrow, lsum, k0 + 96, qrow, hh);
            }
            for (; it < nkt / 2; ++it) {
                ATT_PAIR_HEAD()
                if (k0 <= qmax) attn_unit<true>(sta + 32 * 256, sta + ATT_VOFF, xr, hh, qf, sc, sd, o0, o1, mrow, lsum, k0, qrow, hh);
                if (k0 + 32 <= qmax) attn_unit<true>(stb, sta + ATT_VOFF, xr, 4 + hh, qf, sd, sc, o0, o1, mrow, lsum, k0 + 32, qrow, hh);
                if (k0 + 64 <= qmax) attn_unit<true>(stb + 32 * 256, stb + ATT_VOFF, xr, hh, qf, sc, sd, o0, o1, mrow, lsum, k0 + 64, qrow, hh);
                if (k0 + 96 <= qmax) attn_unit<true>(stc2, stb + ATT_VOFF, xr, 4 + hh, qf, sd, sc, o0, o1, mrow, lsum, k0 + 96, qrow, hh);
            }
#undef ATT_PAIR_HEAD
            const float inv = 1.0f / (lsum + __shfl_xor(lsum, 32));
            bf16_t* op = AB + (size_t)(b * 4096 + qrow) * 1024 + 512 + h * 64 + 4 * hh;
#pragma unroll
            for (int g = 0; g < 4; ++g) { u32x2 w; w.x = pk2(o0[4 * g] * inv, o0[4 * g + 1] * inv); w.y = pk2(o0[4 * g + 2] * inv, o0[4 * g + 3] * inv); *(u32x2*)(op + 8 * g) = w;
                w.x = pk2(o1[4 * g] * inv, o1[4 * g + 1] * inv); w.y = pk2(o1[4 * g + 2] * inv, o1[4 * g + 3] * inv); *(u32x2*)(op + 32 + 8 * g) = w; }
        }
    }
#undef ATT_ISSUE
}
#else
__device__ __forceinline__ void phase_attn(const Params& p, unsigned char* shm) {
    const int widx = p.widx;
    const bf16_t* Q = (const bf16_t*)(p.ws + WS_Q); const bf16_t* Kg = (const bf16_t*)(p.ws + WS_K); const bf16_t* Vt = (const bf16_t*)(p.ws + WS_VT); bf16_t* AB = (bf16_t*)(p.ws + WS_AB);
    const int tid = opaque_tid(widx), wave = widx, lane = tid & 63;
    const int gw = blockIdx.x * 8 + wave, NGW = gridDim.x * 8;
    for (int u = gw; u < T * 8; u += NGW) {
        const int t = u >> 3, h = u & 7, b = t >> 12, s = t & 4095;
        const bf16_t* qp = Q + (size_t)t * 768 + h * 96;
        float m = -1e30f, l = 0.f, o = 0.f;
        for (int k0 = 0; k0 <= s; k0 += 64) {
            const int key = k0 + lane; float sc = -1e30f;
            if (key <= s) { const bf16_t* kp = Kg + (size_t)(b * 4096 + key) * 768 + h * 96; float a = 0.f; for (int d = 0; d < 96; ++d) a += bf2f(qp[d]) * bf2f(kp[d]); sc = a; }
            float mx = sc;
#pragma unroll
            for (int off = 1; off < 64; off <<= 1) mx = fmaxf(mx, __shfl_xor(mx, off));
            const float mnew = fmaxf(m, mx), alpha = exp2f(m - mnew); m = mnew;
            const float pr = exp2f(sc - mnew);
            l = l * alpha + wave_sum(pr); o *= alpha;
            for (int j = 0; j < 64; ++j) { const float pj = __shfl(pr, j); if (k0 + j <= s) { const int kj = k0 + j, kp = (kj & ~12) | ((kj & 4) << 1) | ((kj & 8) >> 1); o += pj * bf2f(Vt[(size_t)(b * 512 + h * 64 + lane) * 4096 + kp]); } }
        }
        AB[(size_t)t * 1024 + 512 + h * 64 + lane] = (bf16_t)f2bf(o / l);
    }
}
#endif

#define LAS __attribute__((address_space(3)))
#define XB_TMO      128
#define XB_XCNT(j)  (256  + 64 * (j))
#define XB_XSUB(j)  (1280 + 64 * (j))
#define XB_XGEN(j)  (2304 + 64 * (j))
#define XB_TOP      3328
#define XB_TOPGEN   3392
#define XCD_BAR_WORDS 3456
#define XB_SPIN_CAP (1u << 18)
__device__ __forceinline__ unsigned xb_ld(unsigned* p)              { return __hip_atomic_load(p, __ATOMIC_RELAXED, __HIP_MEMORY_SCOPE_AGENT); }
__device__ __forceinline__ unsigned xb_add(unsigned* p, unsigned v) { return __hip_atomic_fetch_add(p, v, __ATOMIC_RELAXED, __HIP_MEMORY_SCOPE_AGENT); }
__device__ __forceinline__ unsigned xb_xcc_id() { return (unsigned)__builtin_amdgcn_s_getreg((3 << 11) | 20) & 0xFu; }
#define XB_SPIN(cond, bar) do { unsigned _sp = 0; while (cond) { __builtin_amdgcn_s_sleep(1); \
    if ((++_sp & 255u) == 0u) { if (xb_ld(&(bar)[XB_TMO])) break; if (_sp > XB_SPIN_CAP) { atomicAdd(&(bar)[XB_TMO], 1u); break; } } } } while (0)
struct XcdBarrier { unsigned* bar; unsigned x; volatile LAS unsigned* st; };
__device__ __forceinline__ XcdBarrier xcd_barrier_post(unsigned* bar, volatile LAS unsigned* st) {
    XcdBarrier b; b.bar = bar; b.x = xb_xcc_id(); b.st = st;
    if (threadIdx.x == 0) (void)xb_add(&bar[XB_XCNT(b.x)], 1u);
    return b;
}
__device__ __forceinline__ void xcd_barrier_complete(unsigned* bar, unsigned x, unsigned& nloc, unsigned& nx) {
    const unsigned G = gridDim.x * gridDim.y * gridDim.z;
    unsigned sum, cnt, mine, sp = 0u;
    for (;;) {
        sum = 0u; cnt = 0u; mine = 0u;
#pragma unroll
        for (unsigned j = 0; j < 16; ++j) { const unsigned c = xb_ld(&bar[XB_XCNT(j)]); sum += c; cnt += (c > 0u) ? 1u : 0u; mine = (j == x) ? c : mine; }
        if (sum == G) break;
        __builtin_amdgcn_s_sleep(1);
        if ((++sp & 255u) == 0u) { if (xb_ld(&bar[XB_TMO])) break; if (sp > XB_SPIN_CAP) { atomicAdd(&bar[XB_TMO], 1u); break; } }
    }
    nloc = mine > 0u ? mine : 1u; nx = cnt > 0u ? cnt : 1u;
}
__device__ __forceinline__ void xcd_barrier(const XcdBarrier& b) {
    asm volatile("s_waitcnt vmcnt(0)" ::: "memory");
    __syncthreads();
    if (threadIdx.x == 0) {
        unsigned* bar = b.bar;
        __builtin_amdgcn_s_waitcnt(0);
        unsigned nloc = b.st[0], nx = b.st[1];
        if (nloc == 0u) { xcd_barrier_complete(bar, b.x, nloc, nx); b.st[0] = nloc; b.st[1] = nx; }
        const unsigned old = xb_add(&bar[XB_XSUB(b.x)], 1u);
        const unsigned gen = old / nloc;
        if (old + 1u == (gen + 1u) * nloc) {
            __builtin_amdgcn_fence(__ATOMIC_RELEASE, "agent");
            asm volatile("s_waitcnt vmcnt(0)" ::: "memory");
            const unsigned og = xb_add(&bar[XB_TOP], 1u);
            const unsigned tg = og / nx;
            if (og + 1u == (tg + 1u) * nx) xb_add(&bar[XB_TOPGEN], 1u);
            else XB_SPIN(xb_ld(&bar[XB_TOPGEN]) == tg, bar);
            __builtin_amdgcn_fence(__ATOMIC_ACQUIRE, "agent");
            xb_add(&bar[XB_XGEN(b.x)], 1u);
            asm volatile("s_waitcnt vmcnt(0)" ::: "memory");
        } else {
            XB_SPIN(xb_ld(&bar[XB_XGEN(b.x)]) == gen, bar);
            __builtin_amdgcn_fence(__ATOMIC_ACQUIRE, "agent");
            asm volatile("s_waitcnt vmcnt(0)" ::: "memory");
        }
    }
    __syncthreads();
}

template <class Epi>
__device__ __forceinline__ void gemm_phase(unsigned char* shm, const bf16_t* A, int lda, const bf16_t* Bt, int ldb, int K, int nN, const Epi& epi, int widx) {
    for (int i = 0;; ++i) { int pm, pn; if (!tile_of(i * gridDim.x + blockIdx.x, T / 256, nN, pm, pn)) break; gemm_tile(shm, A, lda, Bt, ldb, K, pm * 256, pn * 256, epi, widx); }
}

__global__ void __launch_bounds__(512, 2) fwd_kernel(Params pin) {
    extern __shared__ __attribute__((aligned(16))) unsigned char shm[];
    const int widx0 = __builtin_amdgcn_readfirstlane((int)(threadIdx.x >> 6));
    volatile LAS unsigned* bst = (volatile LAS unsigned*)(shm + 147456);
    if (threadIdx.x < 2) bst[threadIdx.x] = 0u;
    __syncthreads();
    XcdBarrier gbar = xcd_barrier_post((unsigned*)pin.ws, bst);
    int redone = 0;
    for (int ph = pin.ph_lo; ph < pin.ph_hi; ++ph) {
        if (ph >= 2 && ph < 22 && (ph - 2) % 10 == 7) continue;
        int widx = widx0; asm volatile("" : "+s"(widx));
#if defined(__HIP_DEVICE_COMPILE__)
        typedef const __attribute__((address_space(4))) Params* kparams_ptr;
        kparams_ptr kp = (kparams_ptr)__builtin_amdgcn_kernarg_segment_ptr(); asm volatile("" : "+s"(kp));
        Params p = *kp; p.widx = widx;
#else
        Params p = pin; p.widx = widx;
#endif
        {
            size_t z = 0; asm volatile("" : "+s"(z));
#define LAUNDER(f) p.f += z
            LAUNDER(x); LAUNDER(c); LAUNDER(pos); LAUNDER(ln1_g); LAUNDER(ln2_g); LAUNDER(w_ada); LAUNDER(b_ada); LAUNDER(w_in); LAUNDER(q_norm_g); LAUNDER(w_uq); LAUNDER(kv_norm_g);
            LAUNDER(w_uk); LAUNDER(w_uv); LAUNDER(w_pool); LAUNDER(pool_scale); LAUNDER(p_pool); LAUNDER(p_attn); LAUNDER(w_out); LAUNDER(w_ff1); LAUNDER(w_ff2); LAUNDER(final_g); LAUNDER(out); LAUNDER(ws);
#undef LAUNDER
        }
        unsigned char* ws = p.ws; unsigned char* wb = ws + WS_W;
        float* X = p.out;
        const float* MOD = (const float*)(ws + WS_MOD);
        if (ph == 0) { if (PEN(10)) phase_mod_partials(p, shm); }
        else if (ph == 1) { if (PEN(11)) phase_mod_final(p); }
        else {
            const int l = (ph - 2) / 10, k = (ph - 2) % 10;
            const float* mod = MOD + (size_t)l * 4 * NMOD;
            switch (k) {
            case 0: if (PEN(0)) convert_weights(p, l, shm);
                    if (l == 0) phase_norm(p.x, p.ln1_g, mod + 0, mod + 1024, (bf16_t*)(ws + WS_H), widx);
                    break;
            case 1: if (PEN(1)) { EpiInprojP e{(bf16_t*)(ws + WS_ZA), (bf16_t*)(ws + WS_GA), (bf16_t*)(ws + WS_GB)};
                    gemm_stream<EpiInprojP, false, false, 0, 0, true>(shm, (const bf16_t*)(ws + WS_H), 1024, (const bf16_t*)(wb + W_IN), 1024, 1024, 13, e, widx); } break;
            case 2: if (PEN(2)) phase_prep(p, shm); break;
            case 3: if (PEN(3)) {
                    int gdx = gridDim.x; asm volatile("" : "+s"(gdx)); const bool deal = (gdx == 256);
                    for (int i = 0;; ++i) { int kind, pm, pn;
                        if (deal) { const int bx = blockIdx.x; int c = -1, vt = -1;
                            if (bx < 192) { if (i == 0) { kind = 1; pm = bx / 3; pn = bx % 3; } else if (i == 1) { if (bx < 64) c = 192 + bx; else vt = bx - 64; } else break; }
                            else { if (i < 3) c = 3 * (bx - 192) + i; else break; }
                            if (c >= 0) { if (c < 128) { kind = 0; pm = c >> 1; pn = c & 1; } else { kind = 2; pm = (c - 128) >> 1; pn = (c - 128) & 1; } }
                            if (vt >= 0) { kind = 2; pm = vt >> 1; pn = 2 + (vt & 1); }
                        } else { int q; if (!tile_of(i * gridDim.x + blockIdx.x, T / 256, 9, pm, q)) break; if (q < 2) { kind = 0; pn = q; } else if (q < 5) { kind = 1; pn = q - 2; } else { kind = 2; pn = q - 5; } }
                        if (kind == 0) { EpiPoolP e{(bf16_t*)(ws + WS_AB), p.pool_scale + l * 512}; gemm_tile<EpiPoolP, false, 0, 0, true>(shm, (const bf16_t*)(ws + WS_P) + 256 * pn, 512, (const bf16_t*)(wb + W_POOL) + 256 * pn, 512, 256, pm * 256, pn * 256, e, widx); }
                        else if (kind == 1) { EpiQ e{(bf16_t*)(ws + WS_Q), (const float*)(ws + WS_RSQ), (const float*)(ws + WS_COS), (const float*)(ws + WS_SIN)};
                            gemm_tile(shm, (const bf16_t*)(ws + WS_ZA) + ZC_Q, ZA_LD, (const bf16_t*)(wb + W_UQ), 384, 384, pm * 256, pn * 256, e, widx); }
                        else if (pn < 2) { EpiKP e{(bf16_t*)(ws + WS_K), (const float*)(ws + WS_RSKV)};
                            gemm_tile<EpiKP, false, 0, 0, true>(shm, (const bf16_t*)(ws + WS_ZA) + ZC_KV, ZA_LD, (const bf16_t*)(wb + W_UKV), 256, 256, pm * 256, pn * 256, e, widx); }
                        else { EpiKV e{(bf16_t*)(ws + WS_K), (bf16_t*)(ws + WS_VT), (const float*)(ws + WS_RSKV)};
                            gemm_tile(shm, (const bf16_t*)(ws + WS_ZA) + ZC_KV, ZA_LD, (const bf16_t*)(wb + W_UKV), 256, 256, pm * 256, pn * 256, e, widx); } } } break;
            case 4: if (PEN(4)) phase_attn(p, shm); break;
            case 5: if (PEN(5)) { EpiMergeDualP e{(const bf16_t*)(ws + WS_GA), (const bf16_t*)(ws + WS_GB), (bf16_t*)(ws + WS_MRG)};
                    gemm_stream<EpiMergeDualP, false, true, 512, (long)((W_PB - W_PA) / 2), true>(shm, (const bf16_t*)(ws + WS_AB), 1024, (const bf16_t*)(wb + W_PA), 512, 1024, 4, e, widx); } break;
            case 6: if (PEN(6)) {
                    EpiResNorm<0, true> e{l == 0 ? p.x : X, X, mod + 2048, p.ln2_g + l * 1024, mod + 3072, mod + 4096, (bf16_t*)(ws + WS_H2),
                                    (float*)(ws + WS_SLOTS) + (size_t)(2 * l) * T * 4, (unsigned*)(ws + WS_CNT) + (size_t)(2 * l) * 64 * 64, shm, widx};
                    gemm_stream<EpiResNorm<0, true>, true, false, 0, 0, true>(shm, (const bf16_t*)(ws + WS_MRG), 1024, (const bf16_t*)(wb + W_OUT), 1024, 1024, 4, e, widx); } break;
            case 8: if (PEN(8)) { EpiFF1P e{(bf16_t*)(ws + WS_F)};
                    gemm_stream<EpiFF1P, false, false, 0, 0, true>(shm, (const bf16_t*)(ws + WS_H2), 1024, (const bf16_t*)(wb + W_FF1), 1024, 1024, 16, e, widx); } break;
            case 9: if (PEN(9)) {
                    const float* mod1 = MOD + (size_t)4 * NMOD;
                    float* sl = (float*)(ws + WS_SLOTS) + (size_t)(2 * l + 1) * T * 4; unsigned* cn = (unsigned*)(ws + WS_CNT) + (size_t)(2 * l + 1) * 64 * 64;
                    if (l == 0) { EpiResNorm<0, true> e{X, X, mod + 5120, p.ln1_g + 1024, mod1 + 0, mod1 + 1024, (bf16_t*)(ws + WS_H), sl, cn, shm, widx};
                        gemm_stream<EpiResNorm<0, true>, true, false, 0, 0, true>(shm, (const bf16_t*)(ws + WS_F), 4096, (const bf16_t*)(wb + W_FF2), 4096, 4096, 4, e, widx); }
                    else { EpiResNorm<1, true> e{X, X, mod + 5120, p.final_g, nullptr, nullptr, nullptr, sl, cn, shm, widx};
                        gemm_stream<EpiResNorm<1, true>, true, false, 0, 0, true>(shm, (const bf16_t*)(ws + WS_F), 4096, (const bf16_t*)(wb + W_FF2), 4096, 4096, 4, e, widx); } } break;
            }
        }
        if (ph + 1 < pin.ph_hi) {
#if CG_SYNC
            cg::this_grid().sync();
#else
            if (pin.ph_hi > 1000) cg::this_grid().sync();
            { XcdBarrier gb2 = gbar; asm volatile("" : "+s"(gb2.bar)); xcd_barrier(gb2); }
#endif
            if (PROBE_MASK != 0u) {
                const bool hit = ph >= 2 && ph < 22 && ((PROBE_MASK >> ((ph - 2) % 10)) & 1u);
                if (hit && !redone) { redone = 1; --ph; } else redone = 0;
            }
        }
    }
}

extern "C" void kernel_launch(void* const* d_in, const int* in_sizes, int n_in, void* d_out, int out_size, void* d_ws, size_t ws_size, hipStream_t stream) {
    static int grid = 0;
    if (grid == 0) {
        int dev = 0, cus = 0, per_cu = 0;
        hipGetDevice(&dev);
        hipDeviceGetAttribute(&cus, hipDeviceAttributeMultiprocessorCount, dev);
        hipFuncSetAttribute((const void*)fwd_kernel, hipFuncAttributeMaxDynamicSharedMemorySize, LDS_BYTES);
        hipOccupancyMaxActiveBlocksPerMultiprocessor(&per_cu, (const void*)fwd_kernel, 512, LDS_BYTES);
        if (per_cu < 1) { fprintf(stderr, "kernel_launch: occupancy query says %d blocks/CU\n", per_cu); per_cu = 1; }
        (void)hipGetLastError();
        grid = cus;
    }
    (void)hipMemsetAsync(d_ws, 0, CTL_ZERO_BYTES, stream);
    Params p{};
    p.x = (const float*)d_in[0]; p.c = (const float*)d_in[1]; p.pos = (const int*)d_in[2];
    p.ln1_g = (const float*)d_in[3]; p.ln2_g = (const float*)d_in[4]; p.w_ada = (const float*)d_in[5]; p.b_ada = (const float*)d_in[6];
    p.w_in = (const float*)d_in[7]; p.q_norm_g = (const float*)d_in[8]; p.w_uq = (const float*)d_in[9]; p.kv_norm_g = (const float*)d_in[10];
    p.w_uk = (const float*)d_in[11]; p.w_uv = (const float*)d_in[12]; p.w_pool = (const float*)d_in[13]; p.pool_scale = (const float*)d_in[14];
    p.p_pool = (const float*)d_in[15]; p.p_attn = (const float*)d_in[16]; p.w_out = (const float*)d_in[17]; p.w_ff1 = (const float*)d_in[18];
    p.w_ff2 = (const float*)d_in[19]; p.final_g = (const float*)d_in[20];
    p.out = (float*)d_out; p.ws = (unsigned char*)d_ws;
#if MULTI_LAUNCH
    for (int ph = 0; ph < 22; ++ph) { p.ph_lo = ph; p.ph_hi = ph + 1; hipLaunchKernelGGL(fwd_kernel, dim3(grid), dim3(512), LDS_BYTES, stream, p); }
#else
    p.ph_lo = 0; p.ph_hi = 22;
    void* args[] = {&p};
    hipError_t e = hipLaunchCooperativeKernel((const void*)fwd_kernel, dim3(grid), dim3(512), args, LDS_BYTES, stream);
    if (e != hipSuccess) fprintf(stderr, "cooperative launch failed: %s (grid %d)\n", hipGetErrorString(e), grid);
#endif
}
```
